# Optimizing an MI355X kernel written in HIP

```python
import jax, jax.numpy as jnp
from jax import lax
import numpy as np

D_MODEL = 4096
BATCH = 4
SEQ = 4096
DEPTH = 1
DEC_BATCH = 4
DEC_SEQ = 2048
PAST_LEN = 128

MIX_A = D_MODEL // 2
MIX_B = D_MODEL - MIX_A
A_HEADS = 4
A_HEAD_DIM = MIX_A // A_HEADS
CHUNK = 128
B_HEAD_DIM = 64
B_HEADS = MIX_B // B_HEAD_DIM
LORA_W = 128
LORA_A = 128
LORA_G = 512
B_COLS = 3 * MIX_B + LORA_W + LORA_A + LORA_G
IN_COLS = 2 * MIX_A + B_COLS
N_MEM = 256
X_HEADS = 4
X_HEAD_DIM = D_MODEL // X_HEADS
D_FF = 11008
RMS_EPS = 1e-6
LN_EPS = 1e-5
GN_EPS = 64e-5
L2_EPS = 1e-12

kernel_name = "hybrid_gmlp_rwkv7_bidir_encoder"


def rms_norm(x, g):
    xf = x.astype(jnp.float32)
    y = xf * lax.rsqrt(jnp.mean(xf * xf, axis=-1, keepdims=True) + RMS_EPS)
    return (y * g.astype(jnp.float32)).astype(x.dtype)


def layer_norm(x, g, b, eps):
    xf = x.astype(jnp.float32)
    mu = jnp.mean(xf, axis=-1, keepdims=True)
    var = jnp.mean(jnp.square(xf - mu), axis=-1, keepdims=True)
    return ((xf - mu) * lax.rsqrt(var + eps) * g.astype(jnp.float32) + b.astype(jnp.float32)).astype(x.dtype)


def shift_prev(x):
    return jnp.pad(x, ((0, 0), (1, 0), (0, 0)))[:, :-1]


def shift_next(x):
    return jnp.pad(x, ((0, 0), (0, 1), (0, 0)))[:, 1:]


def chunk_spatial_gating(za, ln_g, ln_b, w_s, b_s):
    u, v = jnp.split(za, 2, axis=-1)
    v = layer_norm(v, ln_g, ln_b, LN_EPS)
    bsz, t, _ = v.shape
    v = v.reshape(bsz, t // CHUNK, CHUNK, A_HEADS, A_HEAD_DIM)
    mixed = jnp.einsum('hpq,bcqhd->bcphd', w_s, v) + b_s.T[None, None, :, :, None]
    return u * mixed.reshape(bsz, t, MIX_A)


def wkv_scan(r, w, k, v, a_neg, b, reverse):
    def step(S, inp):
        r_t, w_t, k_t, v_t, an_t, b_t = inp
        sa = jnp.einsum('bhij,bhj->bhi', S, an_t)
        S = S * w_t[:, :, None, :] + sa[..., None] * b_t[:, :, None, :] + v_t[..., None] * k_t[:, :, None, :]
        return S, jnp.einsum('bhij,bhj->bhi', S, r_t)
    bsz, _, h, n = r.shape
    s0 = jnp.zeros((bsz, h, n, n), jnp.float32)
    xs = tuple(jnp.moveaxis(z, 1, 0) for z in (r, w, k, v, a_neg, b))
    _, ys = lax.scan(step, s0, xs, reverse=reverse)
    return jnp.moveaxis(ys, 0, 1)


def rwkv7_bidir(zb, mu, w0, w_up_decay, a0, w_up_iclr, w_up_gate, k_k, k_a, r_k, gn_g, gn_b):
    zb = zb + mu * (0.5 * (shift_prev(zb) + shift_next(zb)) - zb)
    r, k, v, xw, xa, xg = jnp.split(
        zb, [MIX_B, 2 * MIX_B, 3 * MIX_B, 3 * MIX_B + LORA_W, 3 * MIX_B + LORA_W + LORA_A], axis=-1)
    bsz, t, _ = r.shape
    f32 = jnp.float32

    def heads(z):
        return z.reshape(bsz, t, B_HEADS, B_HEAD_DIM).astype(f32)

    g = jax.nn.sigmoid(xg) @ w_up_gate
    kk = heads(k * k_k)
    kk = kk * lax.rsqrt(jnp.maximum(jnp.sum(kk * kk, axis=-1, keepdims=True), L2_EPS))
    rh, vh = heads(r), heads(v)
    tw = jnp.tanh(xw)
    y = jnp.zeros_like(rh)
    bonus = jnp.zeros_like(rh)
    for d, rev in ((0, False), (1, True)):
        logw = -jax.nn.softplus(-(w0[d] + tw @ w_up_decay[d])) - 0.5
        decay = jnp.exp(-jnp.exp(logw.astype(f32)))
        a = jax.nn.sigmoid(a0[d] + xa @ w_up_iclr[d])
        k_d = k * (1.0 + (a - 1.0) * k_a)
        a_h, k_h = heads(a), heads(k_d)
        y = y + wkv_scan(rh, heads(decay), k_h, vh, -kk, kk * a_h, rev)
        bonus = bonus + jnp.sum(rh * k_h * r_k.astype(f32), axis=-1, keepdims=True) * vh
    mean = jnp.mean(y, axis=-1, keepdims=True)
    var = jnp.mean(jnp.square(y - mean), axis=-1, keepdims=True)
    yn = (y - mean) * lax.rsqrt(var + GN_EPS)
    yn = yn * gn_g.reshape(B_HEADS, B_HEAD_DIM).astype(f32) + gn_b.reshape(B_HEADS, B_HEAD_DIM).astype(f32)
    out = (yn + bonus).reshape(bsz, t, MIX_B).astype(zb.dtype)
    return out * g


def cross_attend(h, mem, w_q, w_kv, w_o):
    bsz, t, _ = h.shape
    q = (h @ w_q).reshape(bsz, t, X_HEADS, X_HEAD_DIM)
    k, v = jnp.split(mem @ w_kv, 2, axis=-1)
    k = k.reshape(bsz, N_MEM, X_HEADS, X_HEAD_DIM)
    v = v.reshape(bsz, N_MEM, X_HEADS, X_HEAD_DIM)
    s = jnp.einsum('bqhd,bkhd->bhqk', q, k).astype(jnp.float32) * (X_HEAD_DIM ** -0.5)
    p = jax.nn.softmax(s, axis=-1).astype(h.dtype)
    o = jnp.einsum('bhqk,bkhd->bqhd', p, v).reshape(bsz, t, D_MODEL)
    return o @ w_o


def conv_ffn(h, w_up, conv_w, conv_b, w_down):
    z = h @ w_up
    zp = jnp.pad(z, ((0, 0), (1, 1), (0, 0)))
    z = conv_w[0] * zp[:, :-2] + conv_w[1] * zp[:, 1:-1] + conv_w[2] * zp[:, 2:] + conv_b
    gate, val = jnp.split(z, 2, axis=-1)
    return (jax.nn.silu(gate) * val) @ w_down


def encoder_layer(x, mem, norm_mix, w_in, mu_shift, ln_v_g, ln_v_b, w_s, b_s, w0, w_up_decay, a0,
                  w_up_iclr, w_up_gate, k_k, k_a, r_k, gn_g, gn_b, w_out, norm_x, norm_mem, w_q, w_kv,
                  w_o, norm_ffn, w_ffn_up, conv_w, conv_b, w_ffn_down):
    z = rms_norm(x, norm_mix) @ w_in
    ya = chunk_spatial_gating(jax.nn.gelu(z[..., :2 * MIX_A]), ln_v_g, ln_v_b, w_s, b_s)
    yb = rwkv7_bidir(z[..., 2 * MIX_A:], mu_shift, w0, w_up_decay, a0, w_up_iclr, w_up_gate,
                     k_k, k_a, r_k, gn_g, gn_b)
    x = x + jnp.concatenate([ya, yb], axis=-1) @ w_out
    x = x + cross_attend(rms_norm(x, norm_x), rms_norm(mem, norm_mem), w_q, w_kv, w_o)
    x = x + conv_ffn(rms_norm(x, norm_ffn), w_ffn_up, conv_w, conv_b, w_ffn_down)
    return x


def trunk(x, mem, layer_params, norm_out):
    for l in range(DEPTH):
        x = encoder_layer(x, mem, *(p[l] for p in layer_params))
    return rms_norm(x, norm_out)


def setup_inputs(seed: int = 0) -> dict:
    key = jax.random.key(seed)
    ks = jax.random.split(key, 40)
    L, D = DEPTH, D_MODEL
    n = lambda i, shape: jax.random.normal(ks[i], shape, jnp.float32)
    u = lambda i, shape, lo, hi: jax.random.uniform(ks[i], shape, jnp.float32, lo, hi)
    return {
        "x_prompt": n(0, (BATCH, SEQ, D)),
        "x_sample": n(1, (DEC_BATCH, DEC_SEQ, D)),
        "mem_prompt": n(2, (BATCH, N_MEM, D)),
        "mem_sample": n(3, (DEC_BATCH, N_MEM, D)),
        "norm_mix": 1.0 + 0.02 * n(4, (L, D)),
        "w_in": n(5, (L, D, IN_COLS)) * D ** -0.5,
        "mu_shift": u(6, (L, B_COLS), 0.0, 1.0),
        "ln_v_g": 1.0 + 0.02 * n(7, (L, MIX_A)),
        "ln_v_b": 0.02 * n(8, (L, MIX_A)),
        "w_s": n(9, (L, A_HEADS, CHUNK, CHUNK)) * CHUNK ** -0.5,
        "b_s": 1.0 + 0.02 * n(10, (L, A_HEADS, CHUNK)),
        "w0": u(11, (L, 2, MIX_B), -6.0, 1.0),
        "w_up_decay": 0.1 * n(12, (L, 2, LORA_W, MIX_B)) * LORA_W ** -0.5,
        "a0": 0.1 * n(13, (L, 2, MIX_B)),
        "w_up_iclr": 0.1 * n(14, (L, 2, LORA_A, MIX_B)) * LORA_A ** -0.5,
        "w_up_gate": n(15, (L, LORA_G, MIX_B)) * LORA_G ** -0.5,
        "k_k": 0.85 + 0.02 * n(16, (L, MIX_B)),
        "k_a": 1.0 + 0.02 * n(17, (L, MIX_B)),
        "r_k": 0.1 * n(18, (L, B_HEADS, B_HEAD_DIM)),
        "gn_g": 1.0 + 0.02 * n(19, (L, MIX_B)),
        "gn_b": 0.02 * n(20, (L, MIX_B)),
        "w_out": n(21, (L, D, D)) * D ** -0.5,
        "norm_x": 1.0 + 0.02 * n(22, (L, D)),
        "norm_mem": 1.0 + 0.02 * n(23, (L, D)),
        "w_q": n(24, (L, D, D)) * D ** -0.5,
        "w_kv": n(25, (L, D, 2 * D)) * D ** -0.5,
        "w_o": n(26, (L, D, D)) * D ** -0.5,
        "norm_ffn": 1.0 + 0.02 * n(27, (L, D)),
        "w_ffn_up": n(28, (L, D, 2 * D_FF)) * D ** -0.5,
        "conv_w": n(29, (L, 3, 2 * D_FF)) * 3 ** -0.5,
        "conv_b": 0.02 * n(30, (L, 2 * D_FF)),
        "w_ffn_down": n(31, (L, D_FF, D)) * D_FF ** -0.5,
        "norm_out": 1.0 + 0.02 * n(32, (D,)),
    }


def reference(x_prompt, x_sample, mem_prompt, mem_sample, norm_mix, w_in, mu_shift, ln_v_g, ln_v_b,
              w_s, b_s, w0, w_up_decay, a0, w_up_iclr, w_up_gate, k_k, k_a, r_k, gn_g, gn_b, w_out,
              norm_x, norm_mem, w_q, w_kv, w_o, norm_ffn, w_ffn_up, conv_w, conv_b, w_ffn_down, norm_out):
    layer_params = (norm_mix, w_in, mu_shift, ln_v_g, ln_v_b, w_s, b_s, w0, w_up_decay, a0, w_up_iclr,
                    w_up_gate, k_k, k_a, r_k, gn_g, gn_b, w_out, norm_x, norm_mem, w_q, w_kv, w_o,
                    norm_ffn, w_ffn_up, conv_w, conv_b, w_ffn_down)
    y_prompt = trunk(x_prompt, mem_prompt, layer_params, norm_out)
    y_sample = trunk(x_sample, mem_sample, layer_params, norm_out)
    return (y_prompt, y_sample)
```

```cpp
#include <hip/hip_runtime.h>
#include <cstdio>
#include <cstdint>

#ifndef I8_LO
#define I8_LO 16
#define I8_HI 40
#endif
#define GAS __attribute__((address_space(1)))
#define LAS __attribute__((address_space(3)))
typedef unsigned short bf16_t;
typedef short bf16x8 __attribute__((ext_vector_type(8)));
typedef float f32x4 __attribute__((ext_vector_type(4)));
typedef float f32x2 __attribute__((ext_vector_type(2)));
typedef unsigned u32x4 __attribute__((ext_vector_type(4)));
typedef unsigned u32x2 __attribute__((ext_vector_type(2)));
typedef int i32x4 __attribute__((ext_vector_type(4)));

constexpr int DM = 4096, MTOK = 24576, NTP = 16384;
constexpr int INC = 11008, DFF = 11008, NUP = 22016;
constexpr int ZB0 = 4096;
constexpr int NH = 32;
constexpr float RMS_EPS = 1e-6f, LN_EPS = 1e-5f, GN_EPS = 64e-5f, L2_EPS = 1e-12f;
constexpr int NPH = 16;
constexpr int UP_EARLY_ITEMS = (64 * (NUP / 32)) * 3 / 8;

constexpr size_t MiB = 1u << 20;
constexpr size_t WS_CTL = 0, CTL_ZERO_BYTES = 1 * MiB;
constexpr size_t WS_WIN = 2 * MiB;
constexpr size_t WS_WOUT = WS_WIN + 86 * MiB;
constexpr size_t WS_WQ = WS_WOUT + 32 * MiB;
constexpr size_t WS_WKV = WS_WQ + 32 * MiB;
constexpr size_t WS_WO = WS_WKV + 64 * MiB;
constexpr size_t WS_WGATE = WS_WO + 32 * MiB;
constexpr size_t WS_WLORA = WS_WGATE + 2 * MiB;
constexpr size_t WS_ALORA = WS_WLORA + 4 * MiB;
constexpr size_t WS_AGATE = WS_ALORA + 12 * MiB;
constexpr size_t WS_ZB = WS_ALORA;
constexpr size_t WS_MEMN = WS_AGATE + 24 * MiB;
constexpr size_t WS_KB = WS_MEMN + 16 * MiB;
constexpr size_t WS_VT = WS_KB + 16 * MiB;
constexpr size_t WS_SB = WS_VT + 16 * MiB;
constexpr size_t WS_H = WS_SB + 6 * MiB;
constexpr size_t WS_C = WS_H + 192 * MiB;
constexpr size_t WS_G = WS_C + 192 * MiB;
constexpr size_t WS_Z = WS_G + 96 * MiB;
constexpr size_t WS_END = WS_Z + 516 * MiB;
static_assert(WS_END <= (size_t)1400 * MiB, "workspace map");
constexpr int CW_BAR = 4096;
constexpr int CW_SS = 16384;
constexpr int CW_LN = CW_SS + 4 * MTOK;
constexpr int CW_ZS = CW_LN + 2 * MTOK;
constexpr int CW_WMAX = CW_ZS + MTOK;
constexpr int CW_RS0 = CW_WMAX + NUP;
constexpr int CW_WMIN = CW_RS0 + MTOK;
static_assert((CW_WMIN + 6144) * 4 <= (int)CTL_ZERO_BYTES, "ctl");

constexpr int RING_BYTES = 131072;
constexpr int XS_OFF = RING_BYTES;
constexpr int MISC_OFF = XS_OFF + 16384;
constexpr int LDS_BYTES = MISC_OFF + 256;
static_assert(LDS_BYTES <= 163840, "LDS");

#define RLX_AGENT __ATOMIC_RELAXED, __HIP_MEMORY_SCOPE_AGENT
#define LDS_WAIT() asm volatile("s_waitcnt lgkmcnt(0)" ::: "memory")
#define VM_WAIT() asm volatile("s_waitcnt vmcnt(0)" ::: "memory")
typedef __bf16 bf16x2v __attribute__((ext_vector_type(2)));
__device__ __forceinline__ unsigned cvt_pk_bf16(float lo, float hi) { return __builtin_bit_cast(unsigned, __builtin_convertvector((f32x2){lo, hi}, bf16x2v)); }
__device__ __forceinline__ float bflo(unsigned u) { return __builtin_bit_cast(float, u << 16); }
__device__ __forceinline__ float bfhi(unsigned u) { return __builtin_bit_cast(float, u & 0xffff0000u); }
__device__ __forceinline__ float bf2f(bf16_t b) { return __builtin_bit_cast(float, ((unsigned)b) << 16); }
__device__ __forceinline__ float fexp(float x) { return __builtin_amdgcn_exp2f(x * 1.4426950408889634f); }
__device__ __forceinline__ float frcp(float x) { return __builtin_amdgcn_rcpf(x); }
__device__ __forceinline__ float sigmoidf_(float x) { return frcp(1.0f + fexp(-x)); }
__device__ __forceinline__ float tanhf_(float x) { return 2.0f * sigmoidf_(2.0f * x) - 1.0f; }
__device__ __forceinline__ float gelu_tanh(float x) { const float u = 0.7978845608028654f * (x + 0.044715f * x * x * x); return x * sigmoidf_(2.0f * u); }
__device__ __forceinline__ f32x4 gelu_tanh4(const f32x4 x) {
    const float C1 = -2.0f * 0.7978845608028654f * 1.4426950408889634f, C2 = C1 * 0.044715f;
    const f32x4 t = x * (x * x * C2 + C1); f32x4 r;
#pragma unroll
    for (int j = 0; j < 4; ++j) r[j] = frcp(1.0f + __builtin_amdgcn_exp2f(t[j]));
    return x * r;
}
__device__ __forceinline__ f32x4 sigmoid_bias4(const f32x4 v, const f32x4 nb, const float sc) {
    const f32x4 t = v * -1.4426950408889634f + nb; f32x4 r;
#pragma unroll
    for (int j = 0; j < 4; ++j) r[j] = frcp(1.0f + __builtin_amdgcn_exp2f(t[j]));
    return r * sc;
}
__device__ __forceinline__ float wave_sum(float v) {
#pragma unroll
    for (int o = 1; o < 64; o <<= 1) v += __shfl_xor(v, o);
    return v;
}
#define DPPF(x, ctrl) __builtin_bit_cast(float, __builtin_amdgcn_update_dpp(0, __builtin_bit_cast(int, (x)), (ctrl), 0xF, 0xF, false))
__device__ __forceinline__ float wave_sum_dpp(float x) {
    x += DPPF(x, 0xB1); x += DPPF(x, 0x4E); x += DPPF(x, 0x141); x += DPPF(x, 0x140);
    const int xi = __builtin_bit_cast(int, x);
    const float a = __builtin_bit_cast(float, __builtin_amdgcn_readlane(xi, 0)), b = __builtin_bit_cast(float, __builtin_amdgcn_readlane(xi, 16));
    const float c = __builtin_bit_cast(float, __builtin_amdgcn_readlane(xi, 32)), d = __builtin_bit_cast(float, __builtin_amdgcn_readlane(xi, 48));
    return (a + b) + (c + d);
}
__device__ __forceinline__ float red8(float x) {
    x += __builtin_bit_cast(float, __builtin_amdgcn_update_dpp(0, __builtin_bit_cast(int, x), 0xB1, 0xF, 0xF, false));
    x += __builtin_bit_cast(float, __builtin_amdgcn_update_dpp(0, __builtin_bit_cast(int, x), 0x4E, 0xF, 0xF, false));
    x += __builtin_bit_cast(float, __builtin_amdgcn_update_dpp(0, __builtin_bit_cast(int, x), 0x141, 0xF, 0xF, false));
    return x;
}
__device__ __forceinline__ void unpack8(const u32x4 w, float (&f)[8]) { f[0] = bflo(w.x); f[1] = bfhi(w.x); f[2] = bflo(w.y); f[3] = bfhi(w.y); f[4] = bflo(w.z); f[5] = bfhi(w.z); f[6] = bflo(w.w); f[7] = bfhi(w.w); }
__device__ __forceinline__ u32x4 pack8(const float (&f)[8]) { u32x4 w; w.x = cvt_pk_bf16(f[0], f[1]); w.y = cvt_pk_bf16(f[2], f[3]); w.z = cvt_pk_bf16(f[4], f[5]); w.w = cvt_pk_bf16(f[6], f[7]); return w; }
__device__ __forceinline__ int seq_len_of_row(int row) { return row < NTP ? 4096 : 2048; }
__device__ __forceinline__ int seq_start_of_row(int row) { return row < NTP ? (row & ~4095) : (NTP + ((row - NTP) & ~2047)); }
__device__ __forceinline__ int seq_of_row(int row) { return row < NTP ? (row >> 12) : 4 + ((row - NTP) >> 11); }
__device__ __forceinline__ int seq_start(int s) { return s < 4 ? s * 4096 : NTP + (s - 4) * 2048; }

#define XB_TMO      128
#define XB_XCNT(j)  (256  + 64 * (j))
#define XB_XSUB(j)  (1280 + 64 * (j))
#define XB_XGEN(j)  (2304 + 64 * (j))
#define XB_TOP      3328
#define XB_TOPGEN   3392
#define XCD_BAR_WORDS 3456
#define XB_SPIN_CAP (1u << 20)
__device__ __forceinline__ unsigned xb_ld(unsigned* p)              { return __hip_atomic_load(p, __ATOMIC_RELAXED, __HIP_MEMORY_SCOPE_AGENT); }
__device__ __forceinline__ unsigned xb_add(unsigned* p, unsigned v) { return __hip_atomic_fetch_add(p, v, __ATOMIC_RELAXED, __HIP_MEMORY_SCOPE_AGENT); }
__device__ __forceinline__ unsigned xb_xcc_id() { return (unsigned)__builtin_amdgcn_s_getreg((3 << 11) | 20) & 0xFu; }
#define XB_SPIN(cond, bar) do { unsigned _sp = 0; while (cond) { __builtin_amdgcn_s_sleep(1); \
    if ((++_sp & 255u) == 0u) { if (xb_ld(&(bar)[XB_TMO])) break; if (_sp > XB_SPIN_CAP) { atomicAdd(&(bar)[XB_TMO], 1u); break; } } } } while (0)
struct XcdBarrier { unsigned* bar; unsigned x; volatile LAS unsigned* st; };
__device__ __forceinline__ XcdBarrier xcd_barrier_post(unsigned* bar, volatile LAS unsigned* st) {
    XcdBarrier b; b.bar = bar; b.x = xb_xcc_id(); b.st = st;
    if (threadIdx.x == 0) (void)xb_add(&bar[XB_XCNT(b.x)], 1u);
    return b;
}
__device__ __forceinline__ void xcd_barrier_complete(unsigned* bar, unsigned x, unsigned& nloc, unsigned& nx) {
    const unsigned G = gridDim.x * gridDim.y * gridDim.z;
    unsigned sum, cnt, mine, sp = 0u;
    for (;;) {
        sum = 0u; cnt = 0u; mine = 0u;
#pragma unroll
        for (unsigned j = 0; j < 16; ++j) { const unsigned c = xb_ld(&bar[XB_XCNT(j)]); sum += c; cnt += (c > 0u) ? 1u : 0u; mine = (j == x) ? c : mine; }
        if (sum == G) break;
        __builtin_amdgcn_s_sleep(1);
        if ((++sp & 255u) == 0u) { if (xb_ld(&bar[XB_TMO])) break; if (sp > XB_SPIN_CAP) { atomicAdd(&bar[XB_TMO], 1u); break; } }
    }
    nloc = mine > 0u ? mine : 1u; nx = cnt > 0u ? cnt : 1u;
}
__device__ __forceinline__ void xcd_barrier(const XcdBarrier& b) {
    asm volatile("s_waitcnt vmcnt(0)" ::: "memory");
    __syncthreads();
    if (threadIdx.x == 0) {
        unsigned* bar = b.bar;
        __builtin_amdgcn_s_waitcnt(0);
        unsigned nloc = b.st[0], nx = b.st[1];
        if (nloc == 0u) { xcd_barrier_complete(bar, b.x, nloc, nx); b.st[0] = nloc; b.st[1] = nx; }
        const unsigned old = xb_add(&bar[XB_XSUB(b.x)], 1u);
        const unsigned gen = old / nloc;
        if (old + 1u == (gen + 1u) * nloc) {
            __builtin_amdgcn_fence(__ATOMIC_RELEASE, "agent");
            asm volatile("s_waitcnt vmcnt(0)" ::: "memory");
            const unsigned og = xb_add(&bar[XB_TOP], 1u);
            const unsigned tg = og / nx;
            if (og + 1u == (tg + 1u) * nx) xb_add(&bar[XB_TOPGEN], 1u);
            else XB_SPIN(xb_ld(&bar[XB_TOPGEN]) == tg, bar);
            __builtin_amdgcn_fence(__ATOMIC_ACQUIRE, "agent");
            xb_add(&bar[XB_XGEN(b.x)], 1u);
            asm volatile("s_waitcnt vmcnt(0)" ::: "memory");
        } else {
            XB_SPIN(xb_ld(&bar[XB_XGEN(b.x)]) == gen, bar);
            __builtin_amdgcn_fence(__ATOMIC_ACQUIRE, "agent");
            asm volatile("s_waitcnt vmcnt(0)" ::: "memory");
        }
    }
    __syncthreads();
}

namespace pg8 {
constexpr int BM = 256, BK = 64, HALF = 128, HTB = HALF * BK * 2, STAGE_BYTES = 8 * HTB, NXCD = 8, WGM = 6;
__host__ __device__ __forceinline__ int lds_byte(int r, int c) { const int st = (r >> 4) * 2 + (c >> 5), rr = r & 15, cc = c & 31, ob = rr * 64 + cc * 2; return st * 1024 + (ob ^ (((ob >> 9) & 1) << 5)); }
__host__ __device__ __forceinline__ void stage_rc(int b, int& R, int& C) { const int st = b / 1024, sb = b % 1024, swz = sb ^ (((sb >> 9) & 1) << 5); R = (st >> 1) * 16 + swz / 64; C = (st & 1) * 32 + (swz % 64) / 2; }
__host__ __device__ __forceinline__ int perm32(int rho) { const int n = rho >> 4, i = rho & 15; return 8 * (i >> 2) + 4 * n + (i & 3); }

struct Unit { const char* A; const char* B; int pm, pn, z, pad; };
__device__ __forceinline__ void tile_order(int L, int nM, int nN, int& pm, int& pn) {
    const int nwg = nM * nN; int wgid = L;
    { const int q = nwg / NXCD, r = nwg % NXCD, xcd = wgid % NXCD, off = wgid / NXCD; wgid = (xcd < r ? xcd * (q + 1) : r * (q + 1) + (xcd - r) * q) + off; }
    const int nig = WGM * nN, gid = wgid / nig, fm = gid * WGM, gsz = (nM - fm) < WGM ? (nM - fm) : WGM;
    pm = fm + ((wgid % nig) % gsz); pn = (wgid % nig) / gsz;
}
struct SchedGrid {
    const char* A; const char* B; int lda, ldb, nM, nN, G, c;
    __device__ __forceinline__ bool next(int i, Unit& u) const {
        const long L = (long)i * G + c; if (L >= (long)nM * nN) return false;
        tile_order((int)L, nM, nN, u.pm, u.pn); u.z = 0; u.pad = 0;
        u.A = A + (size_t)u.pm * 256 * lda * 2; u.B = B + (size_t)u.pn * 256 * ldb * 2; return true;
    }
};

typedef f32x4 Acc[2][2][4][2];

template <class Epi, class Sched, bool ALIGN_EPI, bool SP2, bool I8 = false, bool APERM = false>
__device__ __forceinline__ void gemm_phase(LAS unsigned char* lds, const int K, const int lda, const int ldb, const Sched& S, const Epi& E) {
    const int tid = threadIdx.x, wid = __builtin_amdgcn_readfirstlane(tid >> 6), lane = tid & 63, wr = wid >> 2, wc = wid & 3, fr = lane & 15, fq = lane >> 4;
    int Ko = K; asm volatile("" : "+s"(Ko));
    const int nt = Ko / BK;
    unsigned voffA[2], voffB[2];
#pragma unroll
    for (int i = 0; i < 2; ++i) { int R, C; stage_rc(tid * 16 + i * 8192, R, C); const int Rb = (R & ~31) + perm32(R & 31);
        const int Ra = APERM ? ((R & ~63) + 4 * (R & 15) + ((R >> 4) & 3)) : R;
        voffA[i] = (unsigned)(Ra * lda + C) * 2u; voffB[i] = (unsigned)(Rb * ldb + C) * 2u; }
    const size_t kstep = (size_t)(BK * 2);
    const size_t hstepA = (size_t)HALF * lda * 2, hstepB = (size_t)HALF * ldb * 2;
    const unsigned ldsw = (unsigned)wid * 1024u;
    const int aoff = lds_byte(wr * 64 + fr, fq * 8), boff = lds_byte(wc * 32 + fr, fq * 8);
#define PG8_SA(b, h) (((b) * 2 + (h)) * HTB)
#define PG8_SB(b, h) ((4 + (b) * 2 + (h)) * HTB)
#define PG8_STAGE(bufoff, gbase, voff) do { _Pragma("unroll") for (int _i = 0; _i < 2; ++_i) \
        __builtin_amdgcn_global_load_lds((const unsigned*)((const char*)(gbase) + (voff)[_i]), (LAS unsigned*)(lds + (bufoff) + ldsw + _i * 8192), 16, 0, 0); } while (0)
#define PG8_LDA(dst, b, h) do { _Pragma("unroll") for (int m = 0; m < 4; ++m) _Pragma("unroll") for (int k = 0; k < 2; ++k) dst[m][k] = *(const LAS bf16x8*)(lds + PG8_SA(b, h) + aoff + m * 2048 + k * 1024); } while (0)
#define PG8_LDB(dst, b, h) do { _Pragma("unroll") for (int n = 0; n < 2; ++n) _Pragma("unroll") for (int k = 0; k < 2; ++k) dst[n][k] = *(const LAS bf16x8*)(lds + PG8_SB(b, h) + boff + n * 2048 + k * 1024); } while (0)
#define PG8_MMA(ai, bj, At, Bt) do { __builtin_amdgcn_s_setprio(1); _Pragma("unroll") for (int m = 0; m < 4; ++m) _Pragma("unroll") for (int n = 0; n < 2; ++n) _Pragma("unroll") for (int k = 0; k < 2; ++k) { \
        if constexpr (I8) acc[ai][bj][m][n] = __builtin_bit_cast(f32x4, __builtin_amdgcn_mfma_i32_16x16x64_i8(__builtin_bit_cast(i32x4, Bt[n][k]), __builtin_bit_cast(i32x4, At[m][k]), __builtin_bit_cast(i32x4, acc[ai][bj][m][n]), 0, 0, 0)); \
        else acc[ai][bj][m][n] = __builtin_amdgcn_mfma_f32_16x16x32_bf16(Bt[n][k], At[m][k], acc[ai][bj][m][n], 0, 0, 0); } __builtin_amdgcn_s_setprio(0); } while (0)
#define PG8_WAIT_V(n) asm volatile("s_waitcnt vmcnt(" #n ")" ::: "memory")
#define PG8_WAIT_L(n) asm volatile("s_waitcnt lgkmcnt(" #n ")" ::: "memory")
#define PG8_BAR __builtin_amdgcn_s_barrier()
#define PG8_SCHED __builtin_amdgcn_sched_barrier(0)
    Unit cur, nxt; int ui = 0;
    if (!S.next(0, cur)) return;
    Acc acc;
#pragma unroll
    for (int a = 0; a < 2; ++a)
#pragma unroll
        for (int b = 0; b < 2; ++b)
#pragma unroll
            for (int m = 0; m < 4; ++m)
#pragma unroll
                for (int n = 0; n < 2; ++n) acc[a][b][m][n] = (f32x4){0.f, 0.f, 0.f, 0.f};
    bf16x8 At[4][2], B0[2][2], B1[2][2];
    const char* cA = cur.A; const char* cB = cur.B;
    if constexpr (SP2) {
        PG8_STAGE(PG8_SB(0, 0), cB, voffB); PG8_STAGE(PG8_SB(0, 1), cB + hstepB, voffB); PG8_STAGE(PG8_SA(0, 0), cA, voffA); PG8_STAGE(PG8_SA(0, 1), cA + hstepA, voffA);
        if (wr == 1) PG8_BAR;
        PG8_WAIT_V(2); PG8_BAR;
        PG8_STAGE(PG8_SB(1, 0), cB + kstep, voffB); PG8_STAGE(PG8_SA(1, 0), cA + kstep, voffA); PG8_STAGE(PG8_SB(1, 1), cB + hstepB + kstep, voffB);
        PG8_WAIT_V(6); PG8_BAR;
    } else {
        PG8_STAGE(PG8_SB(0, 0), cB, voffB); PG8_STAGE(PG8_SA(0, 0), cA, voffA); PG8_STAGE(PG8_SB(0, 1), cB + hstepB, voffB); PG8_STAGE(PG8_SA(0, 1), cA + hstepA, voffA);
        if (wr == 1) PG8_BAR;
        PG8_WAIT_V(4); PG8_BAR;
        PG8_STAGE(PG8_SB(1, 0), cB + kstep, voffB); PG8_STAGE(PG8_SA(1, 0), cA + kstep, voffA); PG8_STAGE(PG8_SB(1, 1), cB + hstepB + kstep, voffB);
        PG8_WAIT_V(6); PG8_BAR;
    }
    for (;;) {
        const bool has_next = S.next(ui + 1, nxt);
        const char* nA = has_next ? nxt.A : cA; const char* nB = has_next ? nxt.B : cB;
        for (int t = 0; t < nt; t += 2) {
            const bool last = (t == nt - 2);
            const char* a1 = cA + (size_t)(t + 1) * kstep;
            const char* a2 = last ? nA : cA + (size_t)(t + 2) * kstep; const char* b2 = last ? nB : cB + (size_t)(t + 2) * kstep;
            const char* a3 = a2 + kstep; const char* b3 = b2 + kstep;
            if constexpr (SP2) {
            PG8_LDB(B0, 0, 0); PG8_LDB(B1, 0, 1); PG8_SCHED; PG8_LDA(At, 0, 0); PG8_STAGE(PG8_SA(1, 1), a1 + hstepA, voffA);
            PG8_WAIT_V(8); PG8_WAIT_L(0); PG8_BAR; PG8_MMA(0, 0, At, B0); PG8_MMA(0, 1, At, B1); PG8_BAR; PG8_SCHED;
            PG8_LDA(At, 0, 1); PG8_STAGE(PG8_SB(0, 0), b2, voffB); PG8_STAGE(PG8_SB(0, 1), b2 + hstepB, voffB); PG8_STAGE(PG8_SA(0, 0), a2, voffA);
            PG8_WAIT_V(8); PG8_WAIT_L(0); PG8_BAR; PG8_MMA(1, 0, At, B0); PG8_MMA(1, 1, At, B1); PG8_BAR; PG8_SCHED;
            PG8_LDB(B0, 1, 0); PG8_LDB(B1, 1, 1); PG8_SCHED; PG8_LDA(At, 1, 0); PG8_STAGE(PG8_SA(0, 1), a2 + hstepA, voffA);
            PG8_WAIT_V(8); PG8_WAIT_L(0); PG8_BAR; PG8_MMA(0, 0, At, B0); PG8_MMA(0, 1, At, B1); PG8_BAR; PG8_SCHED;
            PG8_LDA(At, 1, 1); PG8_STAGE(PG8_SB(1, 0), b3, voffB); PG8_STAGE(PG8_SB(1, 1), b3 + hstepB, voffB); PG8_STAGE(PG8_SA(1, 0), a3, voffA);
            PG8_WAIT_V(8); PG8_WAIT_L(0); PG8_BAR; PG8_MMA(1, 0, At, B0); PG8_MMA(1, 1, At, B1); PG8_BAR; PG8_SCHED;
            } else {
            PG8_LDB(B0, 0, 0); PG8_SCHED; PG8_LDA(At, 0, 0); PG8_STAGE(PG8_SA(1, 1), a1 + hstepA, voffA);
            PG8_WAIT_L(8); PG8_BAR; PG8_WAIT_L(0); PG8_MMA(0, 0, At, B0); PG8_BAR; PG8_SCHED;
            PG8_LDB(B1, 0, 1); PG8_STAGE(PG8_SB(0, 0), b2, voffB);
            PG8_BAR; PG8_WAIT_L(0); PG8_MMA(0, 1, At, B1); PG8_BAR;
            PG8_LDA(At, 0, 1); PG8_STAGE(PG8_SA(0, 0), a2, voffA);
            PG8_BAR; PG8_WAIT_L(0); PG8_MMA(1, 0, At, B0); PG8_BAR; PG8_SCHED;
            PG8_STAGE(PG8_SB(0, 1), b2 + hstepB, voffB);
            PG8_WAIT_V(6); PG8_BAR; PG8_MMA(1, 1, At, B1); PG8_BAR;
            PG8_LDB(B0, 1, 0); PG8_SCHED; PG8_LDA(At, 1, 0); PG8_STAGE(PG8_SA(0, 1), a2 + hstepA, voffA);
            PG8_WAIT_L(8); PG8_BAR; PG8_WAIT_L(0); PG8_MMA(0, 0, At, B0); PG8_BAR; PG8_SCHED;
            PG8_LDB(B1, 1, 1); PG8_STAGE(PG8_SB(1, 0), b3, voffB);
            PG8_BAR; PG8_WAIT_L(0); PG8_MMA(0, 1, At, B1); PG8_BAR;
            PG8_LDA(At, 1, 1); PG8_STAGE(PG8_SA(1, 0), a3, voffA);
            PG8_BAR; PG8_WAIT_L(0); PG8_MMA(1, 0, At, B0); PG8_BAR; PG8_SCHED;
            PG8_STAGE(PG8_SB(1, 1), b3 + hstepB, voffB);
            PG8_WAIT_V(6); PG8_BAR; PG8_MMA(1, 1, At, B1); PG8_BAR;
            }
        }
        if constexpr (ALIGN_EPI) { if (wr == 0) PG8_BAR; }
        E(acc, cur, wr, wc, fr, fq);
        if (!has_next) break;
#pragma unroll
        for (int a = 0; a < 2; ++a)
#pragma unroll
            for (int b = 0; b < 2; ++b)
#pragma unroll
                for (int m = 0; m < 4; ++m)
#pragma unroll
                    for (int n = 0; n < 2; ++n) acc[a][b][m][n] = (f32x4){0.f, 0.f, 0.f, 0.f};
        cur = nxt; cA = nA; cB = nB; ++ui;
        if constexpr (ALIGN_EPI) { if (wr == 1) PG8_BAR; }
    }
    PG8_WAIT_V(0);
    if constexpr (!ALIGN_EPI) { if (wr == 0) PG8_BAR; }
    PG8_BAR;
#undef PG8_SA
#undef PG8_SB
#undef PG8_STAGE
#undef PG8_LDA
#undef PG8_LDB
#undef PG8_MMA
#undef PG8_WAIT_V
#undef PG8_WAIT_L
#undef PG8_BAR
#undef PG8_SCHED
}

#define EPI_ROWS_BEGIN _Pragma("unroll") for (int ai = 0; ai < 2; ++ai) _Pragma("unroll") for (int m = 0; m < 4; ++m) {
#define EPI_ROWS_END }
template <int MODE> struct EpiBf16 {
    bf16_t* O; int ldc; const float* bias0; const float* bias1;
    const float* rs0; const float* wmin;
    float* lnst;
    bf16_t* OH; bf16_t* OL;
    __device__ __forceinline__ void operator()(const Acc& acc, const Unit& u, int wr, int wc, int fr, int fq) const {
        const int row0 = u.pm * BM + wr * 64 + fr, col0 = u.pn * BM + wc * 32 + 8 * fq;
        const bool gel = (MODE == 1) && (u.pn < 16);
        f32x4 bv[2][2]; float sc = 1.f;
        if (MODE == 2) { const int bq = u.pn >> 3; const float* bp = (bq < 2 ? bias0 + bq * 2048 : bias1 + (bq - 2) * 2048) + (col0 & 2047); sc = bq < 2 ? 0.6065306597126334f : 1.f;
#pragma unroll
            for (int bj = 0; bj < 2; ++bj)
#pragma unroll
                for (int n = 0; n < 2; ++n) bv[bj][n] = *(const f32x4*)(bp + bj * HALF + 4 * n) * -1.4426950408889634f; }
        EPI_ROWS_BEGIN
            const int row = row0 + ai * HALF + m * 16; float ls1 = 0.f, ls2 = 0.f;
            bf16_t* rowp = O + (size_t)row * ldc + col0;
            if (MODE == 1) { if (u.pn >= 40) rowp = OL + (size_t)row * 768 + (col0 - 10240); }
#pragma unroll
            for (int bj = 0; bj < 2; ++bj) { f32x4 v0 = acc[ai][bj][m][0], v1 = acc[ai][bj][m][1];
                if (MODE == 1) { if (u.pn >= I8_LO && u.pn < I8_HI) { const i32x4 i0 = __builtin_bit_cast(i32x4, v0), i1 = __builtin_bit_cast(i32x4, v1); const float rq = rs0[row] * (1.0f / 127.0f);
                    const float* wp = wmin + (col0 + bj * HALF - 4096);
                    v0 = (f32x4){(float)i0[0], (float)i0[1], (float)i0[2], (float)i0[3]} * (*(const f32x4*)wp * rq); v1 = (f32x4){(float)i1[0], (float)i1[1], (float)i1[2], (float)i1[3]} * (*(const f32x4*)(wp + 4) * rq); } }
                bf16_t* dst = rowp + bj * HALF;
                if (MODE == 1) { if (u.pn >= 16 && u.pn < 40) { const int c = col0 + bj * HALF - 4096; dst = OH + ((size_t)(c >> 6) * MTOK + row) * 64 + (c & 63); } }
                if (MODE == 2) { const int c = col0 + bj * HALF; dst = O + ((size_t)(c >> 6) * MTOK + row) * 64 + (c & 63); }
                if (MODE == 1) { if (gel) { v0 = gelu_tanh4(v0); v1 = gelu_tanh4(v1); } }
                if (MODE == 2) { v0 = sigmoid_bias4(v0, bv[bj][0], sc); v1 = sigmoid_bias4(v1, bv[bj][1], sc); }
                u32x4 w; w.x = cvt_pk_bf16(v0[0], v0[1]); w.y = cvt_pk_bf16(v0[2], v0[3]); w.z = cvt_pk_bf16(v1[0], v1[1]); w.w = cvt_pk_bf16(v1[2], v1[3]);
                *(u32x4*)dst = w;
                if (MODE == 1) { if (u.pn >= 8 && u.pn < 16) {
                    const float a0 = bflo(w.x), a1 = bfhi(w.x), a2 = bflo(w.y), a3 = bfhi(w.y), a4 = bflo(w.z), a5 = bfhi(w.z), a6 = bflo(w.w), a7 = bfhi(w.w);
                    ls1 += ((a0 + a1) + (a2 + a3)) + ((a4 + a5) + (a6 + a7)); ls2 += ((a0 * a0 + a1 * a1) + (a2 * a2 + a3 * a3)) + ((a4 * a4 + a5 * a5) + (a6 * a6 + a7 * a7)); } } }
            if (MODE == 1) { if (u.pn >= 8 && u.pn < 16) { ls1 += __shfl_xor(ls1, 16); ls1 += __shfl_xor(ls1, 32); ls2 += __shfl_xor(ls2, 16); ls2 += __shfl_xor(ls2, 32);
                if (fq == 0) { atomicAdd(lnst + 2 * row, ls1); atomicAdd(lnst + 2 * row + 1, ls2); } } }
        EPI_ROWS_END
    }
};
struct EpiRes {
    const float* resf; const float* resf1; bf16_t* xb; float* ss;
    __device__ __forceinline__ void operator()(const Acc& acc, const Unit& u, int wr, int wc, int fr, int fq) const {
        const int row0 = u.pm * BM + wr * 64 + fr, col0 = u.pn * BM + wc * 32 + 8 * fq;
        EPI_ROWS_BEGIN
            const int row = row0 + ai * HALF + m * 16;
            bf16_t* xp = xb + (size_t)row * DM + col0; float q = 0.f;
#pragma unroll
            for (int bj = 0; bj < 2; ++bj) {
                f32x4 r0, r1;
                if (resf) { const float* rp = (row < NTP ? resf + (size_t)row * DM : resf1 + (size_t)(row - NTP) * DM) + col0 + bj * HALF; r0 = *(const f32x4*)rp; r1 = *(const f32x4*)(rp + 4); }
                else { float f[8]; unpack8(*(const u32x4*)(xp + bj * HALF), f); r0 = (f32x4){f[0], f[1], f[2], f[3]}; r1 = (f32x4){f[4], f[5], f[6], f[7]}; }
                const f32x4 v0 = acc[ai][bj][m][0] + r0, v1 = acc[ai][bj][m][1] + r1;
                q += (v0[0] * v0[0] + v0[1] * v0[1]) + (v0[2] * v0[2] + v0[3] * v0[3]) + (v1[0] * v1[0] + v1[1] * v1[1]) + (v1[2] * v1[2] + v1[3] * v1[3]);
                u32x4 w; w.x = cvt_pk_bf16(v0[0], v0[1]); w.y = cvt_pk_bf16(v0[2], v0[3]); w.z = cvt_pk_bf16(v1[0], v1[1]); w.w = cvt_pk_bf16(v1[2], v1[3]);
                *(u32x4*)(xp + bj * HALF) = w; }
            q += __shfl_xor(q, 16); q += __shfl_xor(q, 32);
            if (fq == 0) atomicAdd(ss + row, q);
        EPI_ROWS_END
    }
};
struct EpiQKV {
    bf16_t* Q; bf16_t* KB; bf16_t* VT; const float* ss;
    __device__ __forceinline__ void operator()(const Acc& acc, const Unit& u, int wr, int wc, int fr, int fq) const {
        const int row0 = u.pm * BM + wr * 64 + fr, col0 = u.pn * BM + wc * 32 + 8 * fq;
        bf16_t* O = u.z == 0 ? Q : (u.z == 1 ? KB : VT); const int ldc = u.z == 2 ? 2048 : DM;
        EPI_ROWS_BEGIN
            const int row = row0 + ai * HALF + m * 16;
            float rs = 1.f; if (u.z == 0) rs = __builtin_amdgcn_rsqf(ss[row] * (1.0f / DM) + RMS_EPS);
            bf16_t* rowp = O + (size_t)row * ldc + col0;
#pragma unroll
            for (int bj = 0; bj < 2; ++bj) { const f32x4 v0 = acc[ai][bj][m][0] * rs, v1 = acc[ai][bj][m][1] * rs;
                u32x4 w; w.x = cvt_pk_bf16(v0[0], v0[1]); w.y = cvt_pk_bf16(v0[2], v0[3]); w.z = cvt_pk_bf16(v1[0], v1[1]); w.w = cvt_pk_bf16(v1[2], v1[3]);
                *(u32x4*)(rowp + bj * HALF) = w; }
        EPI_ROWS_END
    }
};
struct EpiSoftmax {
    bf16_t* P; LAS float* xs; const float* ss;
    __device__ __forceinline__ void operator()(const Acc& acc, const Unit& u, int wr, int wc, int fr, int fq) const {
        const float scale = 0.03125f * 1.4426950408889634f;
        const int srow0 = u.pm * BM + wr * 64 + fr;
        float mx[2][4], sc[2][4];
        EPI_ROWS_BEGIN
            sc[ai][m] = scale * __builtin_amdgcn_rsqf(ss[srow0 + ai * HALF + m * 16] * (1.0f / DM) + RMS_EPS);
            float x = -3.0e38f;
#pragma unroll
            for (int bj = 0; bj < 2; ++bj)
#pragma unroll
                for (int n = 0; n < 2; ++n)
#pragma unroll
                    for (int j = 0; j < 4; ++j) x = fmaxf(x, acc[ai][bj][m][n][j]);
            x = fmaxf(x, __shfl_xor(x, 16)); x = fmaxf(x, __shfl_xor(x, 32));
            if (fq == 0) xs[(ai * HALF + wr * 64 + m * 16 + fr) * 4 + wc] = x;
        EPI_ROWS_END
        LDS_WAIT(); __builtin_amdgcn_s_barrier(); asm volatile("" ::: "memory");
        float sm[2][4];
        EPI_ROWS_BEGIN
            const f32x4 t = *(const LAS f32x4*)(xs + (ai * HALF + wr * 64 + m * 16 + fr) * 4);
            mx[ai][m] = fmaxf(fmaxf(t[0], t[1]), fmaxf(t[2], t[3])) * sc[ai][m];
            float s = 0.f;
#pragma unroll
            for (int bj = 0; bj < 2; ++bj)
#pragma unroll
                for (int n = 0; n < 2; ++n)
#pragma unroll
                    for (int j = 0; j < 4; ++j) s += __builtin_amdgcn_exp2f(acc[ai][bj][m][n][j] * sc[ai][m] - mx[ai][m]);
            s += __shfl_xor(s, 16); s += __shfl_xor(s, 32);
            if (fq == 0) xs[1024 + (ai * HALF + wr * 64 + m * 16 + fr) * 4 + wc] = s;
        EPI_ROWS_END
        LDS_WAIT(); __builtin_amdgcn_s_barrier(); asm volatile("" ::: "memory");
        const int row0 = u.pm * BM + wr * 64 + fr, col0 = u.pn * BM + wc * 32 + 8 * fq;
        EPI_ROWS_BEGIN
            const f32x4 t = *(const LAS f32x4*)(xs + 1024 + (ai * HALF + wr * 64 + m * 16 + fr) * 4);
            sm[ai][m] = frcp((t[0] + t[1]) + (t[2] + t[3]));
            bf16_t* rowp = P + (size_t)(row0 + ai * HALF + m * 16) * 1024 + col0;
#pragma unroll
            for (int bj = 0; bj < 2; ++bj) { f32x4 v0, v1;
#pragma unroll
                for (int j = 0; j < 4; ++j) { v0[j] = __builtin_amdgcn_exp2f(acc[ai][bj][m][0][j] * sc[ai][m] - mx[ai][m]) * sm[ai][m]; v1[j] = __builtin_amdgcn_exp2f(acc[ai][bj][m][1][j] * sc[ai][m] - mx[ai][m]) * sm[ai][m]; }
                u32x4 w; w.x = cvt_pk_bf16(v0[0], v0[1]); w.y = cvt_pk_bf16(v0[2], v0[3]); w.z = cvt_pk_bf16(v1[0], v1[1]); w.w = cvt_pk_bf16(v1[2], v1[3]);
                *(u32x4*)(rowp + bj * HALF) = w; }
        EPI_ROWS_END
    }
};
struct EpiGate {
    bf16_t* CAT; const bf16_t* YF; const bf16_t* ZV; const float* SB; const float* gng; const float* gnb; const float* muv; LAS float* xs2;
    __device__ __forceinline__ void operator()(const Acc& acc, const Unit& u, int wr, int wc, int fr, int fq) const {
        const int rl0 = wr * 64 + fr, row0 = u.pm * BM + rl0;
        EPI_ROWS_BEGIN
            int rl = rl0 + ai * HALF + m * 16; asm volatile("" : "+v"(rl));
            const int row = u.pm * BM + rl;
#pragma unroll
            for (int bj = 0; bj < 2; ++bj) { const int c8 = u.pn * BM + bj * HALF + wc * 32 + 8 * fq;
                float a[8], b[8]; unpack8(*(const u32x4*)(YF + (size_t)row * 2048 + c8), a); unpack8(*(const u32x4*)(YF + (size_t)(MTOK + row) * 2048 + c8), b);
                float s = 0.f, q = 0.f;
#pragma unroll
                for (int j = 0; j < 8; ++j) { const float y = a[j] + b[j]; s += y; q += y * y; }
                s += __shfl_xor(s, 16); s += __shfl_xor(s, 32); q += __shfl_xor(q, 16); q += __shfl_xor(q, 32);
                if (fq == 0) *(LAS f32x2*)(xs2 + (((rl * 4 + 2 * bj + (wc >> 1)) * 2 + (wc & 1)) * 2)) = (f32x2){s, q}; }
            asm volatile("" ::: "memory");
        EPI_ROWS_END
        LDS_WAIT(); __builtin_amdgcn_s_barrier(); asm volatile("" ::: "memory");
#pragma unroll
        for (int bj = 0; bj < 2; ++bj) {
            const int c8 = u.pn * BM + bj * HALF + wc * 32 + 8 * fq, hh = c8 >> 6;
            const f32x4 gg0 = *(const f32x4*)(gng + c8), gg1 = *(const f32x4*)(gng + c8 + 4), gb0 = *(const f32x4*)(gnb + c8), gb1 = *(const f32x4*)(gnb + c8 + 4), mv0 = *(const f32x4*)(muv + c8), mv1 = *(const f32x4*)(muv + c8 + 4);
#pragma unroll
            for (int ai = 0; ai < 2; ++ai)
#pragma unroll
                for (int m = 0; m < 4; ++m) {
                    int rl = rl0 + ai * HALF + m * 16; asm volatile("" : "+v"(rl));
                    const int row = u.pm * BM + rl;
                    const int sst = seq_start_of_row(row), T = seq_len_of_row(row), t = row - sst;
                    float a[8], b[8]; unpack8(*(const u32x4*)(YF + (size_t)row * 2048 + c8), a); unpack8(*(const u32x4*)(YF + (size_t)(MTOK + row) * 2048 + c8), b);
                    const f32x4 st = *(const LAS f32x4*)(xs2 + (rl * 4 + 2 * bj + (wc >> 1)) * 4);
                    const float mean = (st[0] + st[2]) * (1.f / 64.f), var = fmaxf((st[1] + st[3]) * (1.f / 64.f) - mean * mean, 0.f), rstd = __builtin_amdgcn_rsqf(var + GN_EPS);
                    const bf16_t* zp = ZV + ((size_t)hh * MTOK + row) * 64 + (c8 & 63);
                    float vc[8], vp[8], vn[8]; unpack8(*(const u32x4*)zp, vc);
                    { u32x4 wp = *(const u32x4*)(zp - (t > 0 ? 64 : 0)), wn = *(const u32x4*)(zp + (t < T - 1 ? 64 : 0));
                      if (!(t > 0)) wp = (u32x4){0u, 0u, 0u, 0u}; if (!(t < T - 1)) wn = (u32x4){0u, 0u, 0u, 0u};
                      unpack8(wp, vp); unpack8(wn, vn); }
                    const float bon = SB[(size_t)row * NH + hh] + SB[(size_t)(MTOK + row) * NH + hh];
                    float o[8];
#pragma unroll
                    for (int j = 0; j < 8; ++j) { const float gg = j < 4 ? gg0[j & 3] : gg1[j & 3], gb = j < 4 ? gb0[j & 3] : gb1[j & 3], mv = j < 4 ? mv0[j & 3] : mv1[j & 3];
                        const float g = j < 4 ? acc[ai][bj][m][0][j & 3] : acc[ai][bj][m][1][j & 3];
                        const float v_ = vc[j] + mv * (0.5f * (vp[j] + vn[j]) - vc[j]);
                        o[j] = (((a[j] + b[j]) - mean) * rstd * gg + gb + bon * v_) * g; }
                    *(u32x4*)(CAT + (size_t)row * DM + 2048 + c8) = pack8(o);
                    asm volatile("" ::: "memory");
                }
        }
        (void)row0;
    }
};
__device__ __forceinline__ float dpp_ror1(float x) { return __builtin_bit_cast(float, __builtin_amdgcn_update_dpp(0, __builtin_bit_cast(int, x), 0x121, 0xF, 0xF, true)); }
__device__ __forceinline__ float dpp_ror15(float x) { return __builtin_bit_cast(float, __builtin_amdgcn_update_dpp(0, __builtin_bit_cast(int, x), 0x12F, 0xF, 0xF, true)); }
__device__ __forceinline__ float dpp_shr1_old(float old, float x) { return __builtin_bit_cast(float, __builtin_amdgcn_update_dpp(__builtin_bit_cast(int, old), __builtin_bit_cast(int, x), 0x111, 0xF, 0xF, false)); }
__device__ __forceinline__ float dpp_shl1_old(float old, float x) { return __builtin_bit_cast(float, __builtin_amdgcn_update_dpp(__builtin_bit_cast(int, old), __builtin_bit_cast(int, x), 0x101, 0xF, 0xF, false)); }
struct EpiUp {
    bf16_t* Aout; float* ZB; const float* zs; const float* wmax; const float* cw; const float* cb; LAS float* xs;
    __device__ __forceinline__ void operator()(Acc& acc, const Unit& u, int wr, int wc, int fr, int fq) const {
        const int rowb = u.pm * BM + wr * 64 + 4 * fr;
        const int hc0 = u.pn * HALF + wc * 32 + 8 * fq;
#pragma unroll
        for (int ai = 0; ai < 2; ++ai) { const f32x4 rs4 = *(const f32x4*)(zs + rowb + ai * HALF) * (1.0f / 127.0f);
#pragma unroll
            for (int m = 0; m < 4; ++m)
#pragma unroll
                for (int bj = 0; bj < 2; ++bj)
#pragma unroll
                    for (int n = 0; n < 2; ++n) { const i32x4 ia = __builtin_bit_cast(i32x4, acc[ai][bj][m][n]); acc[ai][bj][m][n] = (f32x4){(float)ia[0], (float)ia[1], (float)ia[2], (float)ia[3]} * rs4[m]; } }
        const int lcol = wc * 32 + 8 * fq;
#pragma unroll
        for (int ai = 0; ai < 2; ++ai) {
            if (fr == 0) {
#pragma unroll
                for (int bj = 0; bj < 2; ++bj)
#pragma unroll
                    for (int n = 0; n < 2; ++n) *(LAS f32x4*)(xs + ((ai * 2 + wr) * 2 + 0) * 256 + bj * HALF + lcol + 4 * n) = acc[ai][bj][0][n]; }
            if (fr == 15) {
#pragma unroll
                for (int bj = 0; bj < 2; ++bj)
#pragma unroll
                    for (int n = 0; n < 2; ++n) *(LAS f32x4*)(xs + ((ai * 2 + wr) * 2 + 1) * 256 + bj * HALF + lcol + 4 * n) = acc[ai][bj][3][n]; }
        }
        if (wr == 0 && fr == 0) {
#pragma unroll
            for (int bj = 0; bj < 2; ++bj)
#pragma unroll
                for (int n = 0; n < 2; ++n) { const f32x4 ws = *(const f32x4*)(wmax + bj * DFF + hc0 + 4 * n);
                    *(f32x4*)(ZB + ((size_t)u.pm * 4 + 0) * NUP + bj * DFF + hc0 + 4 * n) = acc[0][bj][0][n] * ws; *(f32x4*)(ZB + ((size_t)u.pm * 4 + 1) * NUP + bj * DFF + hc0 + 4 * n) = acc[0][bj][1][n] * ws; } }
        if (wr == 1 && fr == 15) {
#pragma unroll
            for (int bj = 0; bj < 2; ++bj)
#pragma unroll
                for (int n = 0; n < 2; ++n) { const f32x4 ws = *(const f32x4*)(wmax + bj * DFF + hc0 + 4 * n);
                    *(f32x4*)(ZB + ((size_t)u.pm * 4 + 2) * NUP + bj * DFF + hc0 + 4 * n) = acc[1][bj][2][n] * ws; *(f32x4*)(ZB + ((size_t)u.pm * 4 + 3) * NUP + bj * DFF + hc0 + 4 * n) = acc[1][bj][3][n] * ws; } }
        LDS_WAIT(); __builtin_amdgcn_s_barrier(); asm volatile("" ::: "memory");
#pragma unroll
        for (int n = 0; n < 2; ++n) {
            f32x4 c0[2], c1[2], c2[2], cbv[2];
#pragma unroll
            for (int bj = 0; bj < 2; ++bj) { const int c = bj * DFF + hc0 + 4 * n; const float kc = bj == 0 ? -1.4426950408889634f : -0.6931471805599453f; const f32x4 cs = *(const f32x4*)(wmax + c) * kc;
                c0[bj] = *(const f32x4*)(cw + c) * cs; c1[bj] = *(const f32x4*)(cw + NUP + c) * cs; c2[bj] = *(const f32x4*)(cw + 2 * NUP + c) * cs; cbv[bj] = *(const f32x4*)(cb + c) * kc; }
#pragma unroll
            for (int ai = 0; ai < 2; ++ai) {
                f32x4 up[2], dn[2];
#pragma unroll
                for (int bj = 0; bj < 2; ++bj) {
                    const int blk = ai * 2 + wr;
                    up[bj] = blk > 0 ? *(const LAS f32x4*)(xs + (((blk - 1)) * 2 + 1) * 256 + bj * HALF + lcol + 4 * n) : (f32x4){0.f, 0.f, 0.f, 0.f};
                    dn[bj] = blk < 3 ? *(const LAS f32x4*)(xs + (((blk + 1)) * 2 + 0) * 256 + bj * HALF + lcol + 4 * n) : (f32x4){0.f, 0.f, 0.f, 0.f};
                }
                f32x4 cz[4][2];
#pragma unroll
                for (int bj = 0; bj < 2; ++bj) {
                    const f32x4 V0 = acc[ai][bj][0][n], V1 = acc[ai][bj][1][n], V2 = acc[ai][bj][2][n], V3 = acc[ai][bj][3][n];
                    f32x4 PV, NX;
#pragma unroll
                    for (int j = 0; j < 4; ++j) { PV[j] = dpp_shr1_old(up[bj][j], V3[j]); NX[j] = dpp_shl1_old(dn[bj][j], V0[j]); }
                    cz[0][bj] = __builtin_elementwise_fma(c2[bj], V1, __builtin_elementwise_fma(c1[bj], V0, __builtin_elementwise_fma(c0[bj], PV, cbv[bj])));
                    cz[1][bj] = __builtin_elementwise_fma(c2[bj], V2, __builtin_elementwise_fma(c1[bj], V1, __builtin_elementwise_fma(c0[bj], V0, cbv[bj])));
                    cz[2][bj] = __builtin_elementwise_fma(c2[bj], V3, __builtin_elementwise_fma(c1[bj], V2, __builtin_elementwise_fma(c0[bj], V1, cbv[bj])));
                    cz[3][bj] = __builtin_elementwise_fma(c2[bj], NX, __builtin_elementwise_fma(c1[bj], V3, __builtin_elementwise_fma(c0[bj], V2, cbv[bj])));
                }
#pragma unroll
                for (int m = 0; m < 4; ++m) {
                    f32x4 sg;
#pragma unroll
                    for (int j = 0; j < 4; ++j) sg[j] = frcp(1.0f + __builtin_amdgcn_exp2f(cz[m][0][j]));
                    const f32x4 o = (cz[m][0] * cz[m][1]) * sg;
                    u32x2 w; w.x = cvt_pk_bf16(o[0], o[1]); w.y = cvt_pk_bf16(o[2], o[3]);
                    *(u32x2*)(Aout + (size_t)(rowb + ai * HALF + m) * DFF + hc0 + 4 * n) = w;
                }
            }
        }
    }
};
}


struct Args { const float* in[33]; float* out; unsigned char* ws; int ph_lo, ph_hi, rep, pad; };
struct Frame { LAS unsigned char* lds; int tid, lane, wave, G, bid; };
constexpr int NWAVES = 8;

template <int MAP> __device__ __forceinline__ void transpose_item(const float* W, int K, int N, bf16_t* WT, const float* g, LAS float* scr, int item, int lane) {
    const int nblk = N / 32, kb = item / nblk, nb = item % nblk, k0 = 64 * kb, n0 = 32 * nb;
    int r0 = n0; if (MAP == 1) { const int c = n0 < DFF ? n0 : n0 - DFF; r0 = 256 * (c >> 7) + (c & 127) + (n0 < DFF ? 0 : 128); }
#pragma unroll 8
    for (int i = 0; i < 32; ++i) { const int kk = 2 * i + (lane >> 5); float v = W[(size_t)(k0 + kk) * N + n0 + (lane & 31)]; if (g) v *= g[k0 + kk]; scr[kk * 33 + (lane & 31)] = v; }
    LDS_WAIT(); asm volatile("" ::: "memory");
    const int c = lane & 7;
#pragma unroll
    for (int j = 0; j < 4; ++j) { const int n = (lane >> 3) + 8 * j; const LAS float* s = scr + (8 * c) * 33 + n;
        u32x4 o; o.x = cvt_pk_bf16(s[0 * 33], s[1 * 33]); o.y = cvt_pk_bf16(s[2 * 33], s[3 * 33]); o.z = cvt_pk_bf16(s[4 * 33], s[5 * 33]); o.w = cvt_pk_bf16(s[6 * 33], s[7 * 33]);
        *(u32x4*)(WT + (size_t)(r0 + n) * K + k0 + 8 * c) = o; }
    LDS_WAIT(); asm volatile("" ::: "memory");
}
template <int MAP> __device__ __forceinline__ void convert_items(const float* W, const int K, const int N, bf16_t* WT, const float* g, LAS float* scr, int it, const int it_end, const int it_stride, const int lane, const int col0 = 0, const int ncols = 0) {
    const int nblk = (ncols ? ncols : N) / 32;
    float va[32];
#define CV_LOAD(IT, V) do { const int kb_ = (IT) / nblk, nb_ = (IT) % nblk; const float* p_ = W + (size_t)(64 * kb_ + (lane >> 5)) * N + col0 + 32 * nb_ + (lane & 31); \
        _Pragma("unroll") for (int i = 0; i < 32; ++i) V[i] = p_[(size_t)(2 * i) * N]; } while (0)
    if (it < it_end) CV_LOAD(it, va);
    while (it < it_end) {
        const int itn = it + it_stride;
        float vb[32];
        if (itn < it_end) CV_LOAD(itn, vb);
        const int kb = it / nblk, nb = it % nblk, k0 = 64 * kb, n0 = col0 + 32 * nb;
        int r0 = n0; if (MAP == 1) { const int c = n0 < DFF ? n0 : n0 - DFF; r0 = 256 * (c >> 7) + (c & 127) + (n0 < DFF ? 0 : 128); }
#pragma unroll
        for (int i = 0; i < 32; ++i) scr[(lane & 31) * 66 + 2 * i + (lane >> 5)] = va[i];
        LDS_WAIT(); asm volatile("" ::: "memory");
        const int c = lane & 7, nn = lane >> 3;
        f32x4 g0 = (f32x4){1.f, 1.f, 1.f, 1.f}, g1 = g0;
        if (g) { g0 = *(const f32x4*)(g + k0 + 8 * c); g1 = *(const f32x4*)(g + k0 + 8 * c + 4); }
#pragma unroll
        for (int j = 0; j < 4; ++j) { const int n = nn + 8 * j; const LAS f32x2* s = (const LAS f32x2*)(scr + n * 66 + 8 * c);
            const f32x2 a = s[0], b = s[1], d = s[2], e = s[3];
            u32x4 o; o.x = cvt_pk_bf16(a[0] * g0[0], a[1] * g0[1]); o.y = cvt_pk_bf16(b[0] * g0[2], b[1] * g0[3]); o.z = cvt_pk_bf16(d[0] * g1[0], d[1] * g1[1]); o.w = cvt_pk_bf16(e[0] * g1[2], e[1] * g1[3]);
            *(u32x4*)(WT + (size_t)(r0 + n) * K + k0 + 8 * c) = o; }
        LDS_WAIT(); asm volatile("" ::: "memory");
#pragma unroll
        for (int i = 0; i < 32; ++i) va[i] = vb[i];
        it = itn;
    }
#undef CV_LOAD
}
__device__ __forceinline__ unsigned pack4_i8(float a, float b, float c, float d) {
    const int ia = (int)__builtin_rintf(a), ib = (int)__builtin_rintf(b), ic = (int)__builtin_rintf(c), id = (int)__builtin_rintf(d);
    return ((unsigned)ia & 255u) | (((unsigned)ib & 255u) << 8) | (((unsigned)ic & 255u) << 16) | ((unsigned)id << 24);
}
__device__ __forceinline__ unsigned pack4_i8c(float a, float b, float c, float d) {
    int ia = (int)__builtin_rintf(a), ib = (int)__builtin_rintf(b), ic = (int)__builtin_rintf(c), id = (int)__builtin_rintf(d);
    ia = ia < -127 ? -127 : (ia > 127 ? 127 : ia); ib = ib < -127 ? -127 : (ib > 127 ? 127 : ib); ic = ic < -127 ? -127 : (ic > 127 ? 127 : ic); id = id < -127 ? -127 : (id > 127 ? 127 : id);
    return ((unsigned)ia & 255u) | (((unsigned)ib & 255u) << 8) | (((unsigned)ic & 255u) << 16) | ((unsigned)id << 24);
}
__device__ __forceinline__ void convert_items_i8(const float* W, const int K, const int N, signed char* WQ, const float* g, const float* wmax, LAS float* scr, int it, const int it_end, const int it_stride, const int lane) {
    const int nblk = N / 32;
    float va[32];
#define CV_LOAD(IT, V) do { const int kb_ = (IT) / nblk, nb_ = (IT) % nblk; const float* p_ = W + (size_t)(64 * kb_ + (lane >> 5)) * N + 32 * nb_ + (lane & 31); \
        _Pragma("unroll") for (int i = 0; i < 32; ++i) V[i] = p_[(size_t)(2 * i) * N]; } while (0)
    if (it < it_end) CV_LOAD(it, va);
    while (it < it_end) {
        const int itn = it + it_stride;
        float vb[32];
        if (itn < it_end) CV_LOAD(itn, vb);
        const int kb = it / nblk, nb = it % nblk, k0 = 64 * kb, n0 = 32 * nb;
        const int c_ = n0 < DFF ? n0 : n0 - DFF; const int r0 = 256 * (c_ >> 7) + (c_ & 127) + (n0 < DFF ? 0 : 128);
#pragma unroll
        for (int i = 0; i < 32; ++i) scr[(lane & 31) * 66 + 2 * i + (lane >> 5)] = va[i];
        LDS_WAIT(); asm volatile("" ::: "memory");
        const int c = lane & 7, nn = lane >> 3;
        const f32x4 g0 = *(const f32x4*)(g + k0 + 8 * c), g1 = *(const f32x4*)(g + k0 + 8 * c + 4);
#pragma unroll
        for (int j = 0; j < 4; ++j) { const int n = nn + 8 * j; const LAS f32x2* s = (const LAS f32x2*)(scr + n * 66 + 8 * c);
            const f32x2 a = s[0], b = s[1], d = s[2], e = s[3];
            const float iw = 127.0f * __builtin_amdgcn_rcpf(fmaxf(wmax[n0 + n], 1e-30f));
            u32x2 o; o.x = pack4_i8(a[0] * g0[0] * iw, a[1] * g0[1] * iw, b[0] * g0[2] * iw, b[1] * g0[3] * iw); o.y = pack4_i8(d[0] * g1[0] * iw, d[1] * g1[1] * iw, e[0] * g1[2] * iw, e[1] * g1[3] * iw);
            *(u32x2*)(WQ + (size_t)(r0 + n) * K + k0 + 8 * c) = o; }
        LDS_WAIT(); asm volatile("" ::: "memory");
#pragma unroll
        for (int i = 0; i < 32; ++i) va[i] = vb[i];
        it = itn;
    }
#undef CV_LOAD
}
__device__ __forceinline__ void rms_row_to_bf16(const float* xrow, const float* g, bf16_t* orow, int lane) {
    const f32x4* xr = (const f32x4*)xrow + 2 * lane;
    f32x4 v[8][2]; float s = 0.f;
#pragma unroll
    for (int j = 0; j < 8; ++j) { v[j][0] = xr[128 * j]; v[j][1] = xr[128 * j + 1];
        s += (v[j][0][0] * v[j][0][0] + v[j][0][1] * v[j][0][1]) + (v[j][0][2] * v[j][0][2] + v[j][0][3] * v[j][0][3]) + (v[j][1][0] * v[j][1][0] + v[j][1][1] * v[j][1][1]) + (v[j][1][2] * v[j][1][2] + v[j][1][3] * v[j][1][3]); }
    const float rs = __builtin_amdgcn_rsqf(wave_sum(s) * (1.f / DM) + RMS_EPS);
#pragma unroll
    for (int j = 0; j < 8; ++j) { const f32x4 g0 = ((const f32x4*)g)[2 * lane + 128 * j], g1 = ((const f32x4*)g)[2 * lane + 128 * j + 1];
        const f32x4 a = v[j][0] * rs * g0, b = v[j][1] * rs * g1;
        u32x4 w; w.x = cvt_pk_bf16(a[0], a[1]); w.y = cvt_pk_bf16(a[2], a[3]); w.z = cvt_pk_bf16(b[0], b[1]); w.w = cvt_pk_bf16(b[2], b[3]);
        ((u32x4*)orow)[lane + 64 * j] = w; }
}

__device__ __forceinline__ void rms_row_to_bf16_q8(const float* xrow, const float* g, bf16_t* orow, signed char* qrow, float* qscale, int lane) {
    const f32x4* xr = (const f32x4*)xrow + 2 * lane;
    f32x4 v[8][2]; float s = 0.f;
#pragma unroll
    for (int j = 0; j < 8; ++j) { v[j][0] = xr[128 * j]; v[j][1] = xr[128 * j + 1];
        s += (v[j][0][0] * v[j][0][0] + v[j][0][1] * v[j][0][1]) + (v[j][0][2] * v[j][0][2] + v[j][0][3] * v[j][0][3]) + (v[j][1][0] * v[j][1][0] + v[j][1][1] * v[j][1][1]) + (v[j][1][2] * v[j][1][2] + v[j][1][3] * v[j][1][3]); }
    const float rs = __builtin_amdgcn_rsqf(wave_sum(s) * (1.f / DM) + RMS_EPS);
    unsigned mxb = 0u;
#pragma unroll
    for (int j = 0; j < 8; ++j) { const f32x4 g0 = ((const f32x4*)g)[2 * lane + 128 * j], g1 = ((const f32x4*)g)[2 * lane + 128 * j + 1];
        v[j][0] = v[j][0] * rs * g0; v[j][1] = v[j][1] * rs * g1;
        u32x4 w; w.x = cvt_pk_bf16(v[j][0][0], v[j][0][1]); w.y = cvt_pk_bf16(v[j][0][2], v[j][0][3]); w.z = cvt_pk_bf16(v[j][1][0], v[j][1][1]); w.w = cvt_pk_bf16(v[j][1][2], v[j][1][3]);
        ((u32x4*)orow)[lane + 64 * j] = w;
        { const u32x4 ua = __builtin_bit_cast(u32x4, v[j][0]) & 0x7fffffffu, ub = __builtin_bit_cast(u32x4, v[j][1]) & 0x7fffffffu;
          const unsigned m0 = ua.x > ua.y ? ua.x : ua.y, m1 = ua.z > ua.w ? ua.z : ua.w, m2 = ub.x > ub.y ? ub.x : ub.y, m3 = ub.z > ub.w ? ub.z : ub.w;
          const unsigned m01 = m0 > m1 ? m0 : m1, m23 = m2 > m3 ? m2 : m3, m4 = m01 > m23 ? m01 : m23; mxb = m4 > mxb ? m4 : mxb; } }
#pragma unroll
    for (int o = 1; o < 64; o <<= 1) { const unsigned t = (unsigned)__shfl_xor((int)mxb, o); mxb = t > mxb ? t : mxb; }
    const float mx = fmaxf(__builtin_bit_cast(float, mxb), 1e-30f), iq = 127.0f * __builtin_amdgcn_rcpf(mx);
#pragma unroll
    for (int j = 0; j < 8; ++j) { u32x2 o; o.x = pack4_i8c(v[j][0][0] * iq, v[j][0][1] * iq, v[j][0][2] * iq, v[j][0][3] * iq); o.y = pack4_i8c(v[j][1][0] * iq, v[j][1][1] * iq, v[j][1][2] * iq, v[j][1][3] * iq);
        ((u32x2*)qrow)[lane + 64 * j] = o; }
    if (lane == 0) *qscale = mx * (1.0f / 127.0f);
}
__device__ __forceinline__ void convert_colblock_i8(const float* W, const int ldw, const int c0, signed char* WQ, float* wmax_out, LAS unsigned char* lds, const int wave, const int lane) {
    LAS unsigned* cm = (LAS unsigned*)(lds + 131072);
    { const float* p = W + (size_t)(512 * wave + (lane >> 5)) * ldw + c0 + (lane & 31); unsigned m = 0u;
#pragma unroll 16
      for (int i = 0; i < 256; ++i) { const unsigned a = __builtin_bit_cast(unsigned, p[(size_t)(2 * i) * ldw]) & 0x7fffffffu; m = a > m ? a : m; }
      const unsigned t = (unsigned)__shfl_xor((int)m, 32); m = t > m ? t : m;
      if (lane < 32) cm[wave * 32 + lane] = m; }
    LDS_WAIT(); __syncthreads();
    if (wave == 0 && lane < 32) { unsigned m = 0u;
#pragma unroll
        for (int w = 0; w < 8; ++w) { const unsigned t = cm[w * 32 + lane]; m = t > m ? t : m; }
        cm[256 + lane] = m; wmax_out[lane] = __builtin_bit_cast(float, m); }
    LDS_WAIT(); __syncthreads();
    LAS float* scr = (LAS float*)(lds + wave * 16384);
    for (int kb = wave; kb < 64; kb += 8) {
        const float* p_ = W + (size_t)(64 * kb + (lane >> 5)) * ldw + c0 + (lane & 31);
        float va[32];
#pragma unroll
        for (int i = 0; i < 32; ++i) va[i] = p_[(size_t)(2 * i) * ldw];
#pragma unroll
        for (int i = 0; i < 32; ++i) scr[(lane & 31) * 66 + 2 * i + (lane >> 5)] = va[i];
        LDS_WAIT(); asm volatile("" ::: "memory");
        const int c = lane & 7, nn = lane >> 3;
#pragma unroll
        for (int j = 0; j < 4; ++j) { const int n = nn + 8 * j; const LAS f32x2* s = (const LAS f32x2*)(scr + n * 66 + 8 * c);
            const f32x2 a = s[0], b = s[1], d = s[2], e = s[3];
            const float iw = 127.0f * __builtin_amdgcn_rcpf(fmaxf(__builtin_bit_cast(float, cm[256 + n]), 1e-30f));
            u32x2 o; o.x = pack4_i8c(a[0] * iw, a[1] * iw, b[0] * iw, b[1] * iw); o.y = pack4_i8c(d[0] * iw, d[1] * iw, e[0] * iw, e[1] * iw);
            *(u32x2*)(WQ + (size_t)n * 4096 + 64 * kb + 8 * c) = o; }
        LDS_WAIT(); asm volatile("" ::: "memory");
    }
    __syncthreads();
}
enum { I_XP = 0, I_XS, I_MP, I_MS, I_NMIX, I_WIN, I_MU, I_LNG, I_LNB, I_WS, I_BS, I_W0, I_WDEC, I_A0, I_WICLR, I_WGATE, I_KK, I_KA, I_RK, I_GNG, I_GNB, I_WOUT, I_NX, I_NMEM, I_WQ, I_WKV, I_WO, I_NFFN, I_WUP, I_CW, I_CB, I_WDOWN, I_NOUT };

#define KARG_PTRS ((const float* const __attribute__((address_space(4)))*)__builtin_amdgcn_kernarg_segment_ptr())
#define ARGIN(k) (KARG_PTRS[(k)])
#define ARG_OUT ((float*)KARG_PTRS[33])
#define ARG_WS ((unsigned char*)KARG_PTRS[34])
#define ARG_INT(i) (((const int __attribute__((address_space(4)))*)__builtin_amdgcn_kernarg_segment_ptr())[70 + (i)])
__global__ void __launch_bounds__(NWAVES * 64, 2) fwd(Args) {
    extern __shared__ __attribute__((aligned(16))) unsigned char lds_raw[];
    Frame F; F.lds = (LAS unsigned char*)lds_raw; F.tid = threadIdx.x; F.lane = F.tid & 63; F.wave = __builtin_amdgcn_readfirstlane(F.tid >> 6); F.G = gridDim.x; F.bid = blockIdx.x;
    volatile LAS unsigned* MISC = (volatile LAS unsigned*)(F.lds + MISC_OFF);
    unsigned char* ws = ARG_WS;
    unsigned* ctl = (unsigned*)(ws + WS_CTL);
    for (int u = F.tid; u < 64; u += NWAVES * 64) MISC[u] = 0u;
    __syncthreads();
    const int lo = ARG_INT(0), hi = ARG_INT(1);
    const int rep = ARG_INT(2);
    const bool multi = (hi - lo) > 1;
    XcdBarrier bar; bar.bar = ctl + CW_BAR; bar.x = 0; bar.st = nullptr;
    if (multi) bar = xcd_barrier_post(ctl + CW_BAR, MISC + 8);
#ifndef PH_MASK
#define PH_MASK 0x1ffff
#endif
#define IN(k) ((((PH_MASK) >> (k)) & 1) && lo <= (k) && (k) < hi)
#define SEAM(k) do { if (IN((k) + 1)) xcd_barrier(bar); } while (0)
    LAS float* xs = (LAS float*)(F.lds + XS_OFF);
    const int gw = F.bid * NWAVES + F.wave, NGW = F.G * NWAVES;
    float* ss1 = (float*)(ctl + CW_SS); float* ss2 = ss1 + MTOK; float* ss3 = ss2 + MTOK; float* ssd = ss3 + MTOK;
    bf16_t* Wt_in = (bf16_t*)(ws + WS_WIN); bf16_t* Wt_down = (bf16_t*)(ws + WS_WIN); bf16_t* Wt_out = (bf16_t*)(ws + WS_WOUT); bf16_t* Wt_q = (bf16_t*)(ws + WS_WQ);
    bf16_t* Wt_kv = (bf16_t*)(ws + WS_WKV); bf16_t* Wt_o = (bf16_t*)(ws + WS_WO); bf16_t* Wt_gate = (bf16_t*)(ws + WS_WGATE); bf16_t* Wt_lora = (bf16_t*)(ws + WS_WLORA);
    bf16_t* A_lora = (bf16_t*)(ws + WS_ALORA); bf16_t* A_gate = (bf16_t*)(ws + WS_AGATE); float* ZBf = (float*)(ws + WS_ZB);
    bf16_t* memn = (bf16_t*)(ws + WS_MEMN); bf16_t* KVB = (bf16_t*)(ws + WS_KB);
    bf16_t* WQR = (bf16_t*)(ws + WS_WQ);
    bf16_t* KWt = (bf16_t*)(ws + WS_Z); bf16_t* VWt = (bf16_t*)(ws + WS_Z + 64 * MiB);
    float* SBN = (float*)(ws + WS_SB);
    bf16_t* H0 = (bf16_t*)(ws + WS_H); bf16_t* YF = (bf16_t*)(ws + WS_H); bf16_t* X1B = (bf16_t*)(ws + WS_H);
    bf16_t* CAT = (bf16_t*)(ws + WS_C); signed char* WupQ = (signed char*)(ws + WS_C);
    signed char* X2Q = (signed char*)(ws + WS_G);
    float* zsc = (float*)(ctl + CW_ZS); float* wmaxf = (float*)(ctl + CW_WMAX);
    signed char* H0Q = (signed char*)(ws + WS_G);
    signed char* WinQ = (signed char*)(ws + WS_C);
    bf16_t* GB = (bf16_t*)(ws + WS_G); bf16_t* PB = (bf16_t*)(ws + WS_G);
    bf16_t* ZA = (bf16_t*)(ws + WS_Z); bf16_t* ZL = (bf16_t*)(ws + WS_Z + 192 * MiB); bf16_t* ZH = (bf16_t*)(ws + WS_Z + 228 * MiB); bf16_t* ACT = (bf16_t*)(ws + WS_Z);
    bf16_t* LORA = (bf16_t*)ARG_OUT;

    if (IN(0)) {
        LAS float* scr = (LAS float*)(F.lds + F.wave * 16384);
        constexpr int I_IN = 64 * (INC / 32), I_GT = 8 * (2048 / 32);
        for (int cb = (I8_LO - 16) * 8 + F.bid; cb < (I8_HI - 16) * 8; cb += F.G) convert_colblock_i8(ARGIN(I_WIN), INC, ZB0 + 32 * cb, WinQ + (size_t)(32 * cb) * DM, (float*)(ctl + CW_WMIN) + 32 * cb, F.lds, F.wave, F.lane);
        convert_items<0>(ARGIN(I_WIN), DM, INC, Wt_in, nullptr, scr, gw, 64 * (I8_LO * 256 / 32), NGW, F.lane, 0, I8_LO * 256);
        convert_items<0>(ARGIN(I_WIN), DM, INC, Wt_in, nullptr, scr, gw, 64 * ((INC - I8_HI * 256) / 32), NGW, F.lane, I8_HI * 256, INC - I8_HI * 256);
        convert_items<0>(ARGIN(I_WGATE), 512, 2048, Wt_gate, nullptr, scr, gw, I_GT, NGW, F.lane);
        for (int i = F.bid * 512 + F.tid; i < 8192 * 32; i += F.G * 512) {
            const int n = i & 8191, k8 = i >> 13, bq = n >> 11, c = n & 2047, k0 = 8 * k8;
            float f[8];
#pragma unroll
            for (int j = 0; j < 8; ++j) { const int k = k0 + j; float v = 0.f;
                if (bq < 2) { if (k < 128) v = ARGIN(I_WDEC)[((size_t)bq * 128 + k) * 2048 + c]; }
                else { if (k >= 128) v = ARGIN(I_WICLR)[((size_t)(bq - 2) * 128 + (k - 128)) * 2048 + c]; }
                f[j] = v; }
            *(u32x4*)(Wt_lora + (size_t)n * 256 + k0) = pack8(f);
        }
        for (int m = gw; m < MTOK; m += NGW) rms_row_to_bf16_q8(m < NTP ? ARGIN(I_XP) + (size_t)m * DM : ARGIN(I_XS) + (size_t)(m - NTP) * DM, ARGIN(I_NMIX), H0 + (size_t)m * DM, H0Q + (size_t)m * DM, (float*)(ctl + CW_RS0) + m, F.lane);
        for (int m = gw; m < 2048; m += NGW) rms_row_to_bf16(m < 1024 ? ARGIN(I_MP) + (size_t)m * DM : ARGIN(I_MS) + (size_t)(m - 1024) * DM, ARGIN(I_NMEM), memn + (size_t)m * DM, F.lane);
        SEAM(0);
    }
    if (IN(1)) {
        struct SchedZ { const char* A; const char* B; int lda, nT, lo, skip, brow0, G, c;
            __device__ __forceinline__ bool next(int i, pg8::Unit& u) const {
                const long L = (long)i * G + c; if (L >= (long)96 * nT) return false;
                int j; pg8::tile_order((int)L, 96, nT, u.pm, j); u.pn = j < lo ? j : j + skip; u.z = 0; u.pad = 0;
                u.A = A + (size_t)u.pm * 256 * lda * 2; u.B = B + (size_t)(u.pn - brow0) * 256 * lda * 2; return true; } };
        pg8::EpiBf16<1> E{ZA, DM, nullptr, nullptr, (const float*)(ctl + CW_RS0), (const float*)(ctl + CW_WMIN), (float*)(ctl + CW_LN), ZH, ZL};
        {
            SchedZ S8{(const char*)H0Q, (const char*)WinQ, DM / 2, I8_HI - I8_LO, 0, I8_LO, 16, F.G, F.bid};
            pg8::gemm_phase<pg8::EpiBf16<1>, SchedZ, true, true, true>(F.lds, DM / 2, DM / 2, DM / 2, S8, E); }
        SchedZ S{(const char*)H0, (const char*)Wt_in, DM, INC / 256 - (I8_HI - I8_LO), I8_LO, I8_HI - I8_LO, 0, F.G, F.bid};
        pg8::gemm_phase<pg8::EpiBf16<1>, SchedZ, true, true>(F.lds, DM, DM, DM, S, E);
        {
            const int nun = (MTOK / 256) * (INC / 256 - (I8_HI - I8_LO)), rounds = (nun + F.G - 1) / F.G, nbusy = nun - (rounds - 1) * F.G;
            const int nidle = F.G - nbusy;
            LAS float* scr = (LAS float*)(F.lds + F.wave * 16384);
            constexpr int I_SQ = 64 * (DM / 32), I_KV = 64 * (2 * DM / 32);
            const int w0 = (nidle > 0) ? ((F.bid - nbusy) * NWAVES + F.wave) : gw, nw = (nidle > 0) ? nidle * NWAVES : NGW;
            if (nidle == 0 || F.bid >= nbusy) {
                convert_items<0>(ARGIN(I_WOUT), DM, DM, Wt_out, nullptr, scr, w0, I_SQ, nw, F.lane);
                { const float* wq = ARGIN(I_WQ); const float* nx = ARGIN(I_NX);
                  const int t0_ = (nidle > 0) ? (F.bid - nbusy) * 512 + F.tid : F.bid * 512 + F.tid, tn_ = (nidle > 0) ? nidle * 512 : F.G * 512;
                  for (int i = t0_; i < DM * DM / 8; i += tn_) { const float g_ = nx[i >> 9]; const f32x4 a = ((const f32x4*)wq)[2 * i] * g_, b = ((const f32x4*)wq)[2 * i + 1] * g_;
                      u32x4 w; w.x = cvt_pk_bf16(a[0], a[1]); w.y = cvt_pk_bf16(a[2], a[3]); w.z = cvt_pk_bf16(b[0], b[1]); w.w = cvt_pk_bf16(b[2], b[3]); ((u32x4*)WQR)[i] = w; } }
                convert_items<0>(ARGIN(I_WKV), DM, 2 * DM, Wt_kv, nullptr, scr, w0, I_KV, nw, F.lane);
                convert_items<0>(ARGIN(I_WO), DM, DM, Wt_o, nullptr, scr, w0, I_SQ, nw, F.lane);
            }
        }
        SEAM(1);
    }
    if (IN(2)) {
        const float* mu = ARGIN(I_MU);
        {   constexpr int NIT = MTOK * 96; const int stride = F.G * 512;
            for (int base = F.bid * 512 + F.tid; base < NIT; base += 4 * stride) {
                u32x4 C[4], P[4], N[4]; f32x4 M0[4], M1[4];
#pragma unroll
                for (int k = 0; k < 4; ++k) { const int i_ = base + k * stride, i = i_ < NIT ? i_ : NIT - 1; const int row = i / 96, o = i - row * 96;
                    const int s0 = seq_start_of_row(row), T = seq_len_of_row(row), t = row - s0;
                    const bf16_t* zp = ZL + (size_t)row * 768 + 8 * o;
                    C[k] = *(const u32x4*)zp; P[k] = *(const u32x4*)(zp - (t > 0 ? 768 : 0)); N[k] = *(const u32x4*)(zp + (t < T - 1 ? 768 : 0));
                    M0[k] = *(const f32x4*)(mu + 6144 + 8 * o); M1[k] = *(const f32x4*)(mu + 6144 + 8 * o + 4); }
#pragma unroll
                for (int k = 0; k < 4; ++k) { const int i = base + k * stride; const int ic = i < NIT ? i : NIT - 1; const int row = ic / 96, o = ic - row * 96;
                    const int s0 = seq_start_of_row(row), T = seq_len_of_row(row), t = row - s0;
                    float c[8], p[8], n[8]; unpack8(C[k], c);
                    { u32x4 wp = P[k], wn = N[k]; if (!(t > 0)) wp = (u32x4){0u, 0u, 0u, 0u}; if (!(t < T - 1)) wn = (u32x4){0u, 0u, 0u, 0u}; unpack8(wp, p); unpack8(wn, n); }
                    float f[8];
#pragma unroll
                    for (int j = 0; j < 8; ++j) { const float m_ = j < 4 ? M0[k][j & 3] : M1[k][j & 3]; const float v = c[j] + m_ * (0.5f * (p[j] + n[j]) - c[j]);
                        f[j] = o < 16 ? tanhf_(v) : (o < 32 ? v : sigmoidf_(v)); }
                    if (i < NIT) { if (o < 32) *(u32x4*)(A_lora + (size_t)row * 256 + 8 * o) = pack8(f); else *(u32x4*)(A_gate + (size_t)row * 512 + 8 * (o - 32)) = pack8(f); }
                }
            }
        }
        {
            const float* wu = ARGIN(I_WUP); const float* nf = ARGIN(I_NFFN);
            if (F.G != 256)
            for (int it = gw; it < (NUP / 256) * 64; it += NGW) { const int nb = it % (NUP / 256), ks = it / (NUP / 256); unsigned m0 = 0u, m1 = 0u, m2 = 0u, m3 = 0u;
                const float* p = wu + (size_t)(ks * 64) * NUP + 256 * nb + 4 * F.lane;
#pragma unroll 16
                for (int k = 0; k < 64; ++k) { const f32x4 w4 = *(const f32x4*)(p + (size_t)k * NUP); const float g_ = nf[ks * 64 + k];
                    const unsigned b0 = __builtin_bit_cast(unsigned, w4[0] * g_) & 0x7fffffffu, b1 = __builtin_bit_cast(unsigned, w4[1] * g_) & 0x7fffffffu, b2 = __builtin_bit_cast(unsigned, w4[2] * g_) & 0x7fffffffu, b3 = __builtin_bit_cast(unsigned, w4[3] * g_) & 0x7fffffffu;
                    m0 = b0 > m0 ? b0 : m0; m1 = b1 > m1 ? b1 : m1; m2 = b2 > m2 ? b2 : m2; m3 = b3 > m3 ? b3 : m3; }
                unsigned* dst = (unsigned*)(ctl + CW_WMAX) + 256 * nb + 4 * F.lane;
                atomicMax(dst + 0, m0); atomicMax(dst + 1, m1); atomicMax(dst + 2, m2); atomicMax(dst + 3, m3); }
        }
        SEAM(2);
    }
    if (IN(3)) {
        pg8::SchedGrid S{(const char*)A_lora, (const char*)Wt_lora, 256, 256, MTOK / 256, 32, F.G, F.bid};
        pg8::EpiBf16<2> E{LORA, 8192, ARGIN(I_W0), ARGIN(I_A0), nullptr, nullptr, nullptr, nullptr, nullptr};
        pg8::gemm_phase<pg8::EpiBf16<2>, pg8::SchedGrid, true, true>(F.lds, 256, 256, 256, S, E);
        SEAM(3);
    }
    if (IN(4)) {
        constexpr int TC = 16, SM_LD = 136, TR_LD = 40;
        constexpr int OFF_AH = 0, OFF_RH = 2176, OFF_BH = 4352, OFF_KH = 6528, OFF_PH = 8704, OFF_QH = 10880, OFF_BT = 13056, OFF_KT = OFF_BT + 2560, OFF_VT = OFF_KT + 2560, OFF_CL = OFF_VT + 2560, IB_BYTES = OFF_CL + 256;
        typedef short bf16x4 __attribute__((ext_vector_type(4)));
#define CVT4(v) __builtin_bit_cast(bf16x4, (u32x2){cvt_pk_bf16((v)[0], (v)[1]), cvt_pk_bf16((v)[2], (v)[3])})
#define CAT8(lo, hi) __builtin_shufflevector((lo), (hi), 0, 1, 2, 3, 4, 5, 6, 7)
#define MFMA32(a, b, c) __builtin_amdgcn_mfma_f32_16x16x32_bf16((a), (b), (c), 0, 0, 0)
#define MFMA16(a, b, c) __builtin_amdgcn_mfma_f32_16x16x16bf16_1k((a), (b), (c), 0, 0, 0)
        const int role = F.wave >> 2, w4 = F.wave & 3, fr = F.lane & 15, fq = F.lane >> 4;
        const f32x4 zero4 = (f32x4){0.f, 0.f, 0.f, 0.f};
        const bool abs_in_scan = (F.G == 256);
        const int awv = F.bid * 4 + (F.wave & 3), acb = awv % (NUP / 256), arow0 = (awv / (NUP / 256)) * 373;
        const float* wabs = ARGIN(I_WUP) + 256 * acb + 4 * F.lane; const float* nfa = ARGIN(I_NFFN);
        unsigned am0 = 0u, am1 = 0u, am2 = 0u, am3 = 0u;
        for (int id2 = 2 * F.bid; id2 < 512; id2 += 2 * F.G) for (int item = 0; item < 2; ++item) {
            const int id = id2 >> 1;
            const int seq = (item == 0 ? 0 : 4) + (id >> 6), hd = id & 63, h = hd >> 1, dir = hd & 1;
            const int T = item == 0 ? 4096 : 2048, s0 = seq_start(seq);
            const int nch = T / TC;
            LAS unsigned char* ibase = F.lds;
            LAS bf16_t* ybase = (LAS bf16_t*)(F.lds + 2 * IB_BYTES);
            LAS float* rhoS = (LAS float*)(F.lds + 2 * IB_BYTES + 4096) + w4 * 16;
            const int ch = h * 64 + F.lane;
            const float mu_r = ARGIN(I_MU)[ch], mu_k = ARGIN(I_MU)[2048 + ch], mu_v = ARGIN(I_MU)[4096 + ch];
            const float kkc = ARGIN(I_KK)[ch], kac = ARGIN(I_KA)[ch], rkc = ARGIN(I_RK)[ch];
            f32x4 S[4] = {zero4, zero4, zero4, zero4};
            bf16_t* Yd = YF + (size_t)dir * MTOK * 2048;
            float* SBd = SBN + (size_t)dir * MTOK * NH;
            const int sgn = dir ? -1 : 1;
            unsigned eoff[16], zoff[6];
#pragma unroll
            for (int s = 0; s < 16; ++s) eoff[s] = (unsigned)((dir ? 15 - s : s) * 128 + F.lane * 2);
#pragma unroll
            for (int k = 0; k < 6; ++k) zoff[k] = (unsigned)((dir ? 5 - k : k) * 128 + F.lane * 2);
#define SCAN_ISSUE(CH, ER, AR, ZR) do { const int chc_ = (CH) < nch ? (CH) : nch - 1; const int cb_ = chc_ * TC; const int tq_ = dir ? (T - 1 - (cb_ + 4 * w4)) : (cb_ + 4 * w4); \
                    const char* eb_ = (const char*)(LORA + ((size_t)(dir * 32 + h) * MTOK + s0 + (dir ? T - 1 - cb_ - 15 : cb_)) * 64); \
                    const char* ab_ = (const char*)(LORA + ((size_t)((2 + dir) * 32 + h) * MTOK + s0 + (dir ? tq_ - 3 : tq_)) * 64); \
                    const char* zb0_ = (const char*)(ZH + ((ptrdiff_t)h * MTOK + s0 + (dir ? tq_ - 4 : tq_ - 1)) * 64); \
                    const char* zb1_ = zb0_ + (size_t)32 * MTOK * 128; const char* zb2_ = zb0_ + (size_t)64 * MTOK * 128; \
                    _Pragma("unroll") for (int s = 0; s < 16; ++s) ER[s] = (unsigned)*(const bf16_t*)(eb_ + eoff[s]); \
                    _Pragma("unroll") for (int q = 0; q < 4; ++q) AR[q] = (unsigned)*(const bf16_t*)(ab_ + eoff[dir ? q + 12 : q]); \
                    _Pragma("unroll") for (int k = 0; k < 6; ++k) { ZR[k][0] = (unsigned)*(const bf16_t*)(zb0_ + zoff[k]); ZR[k][1] = (unsigned)*(const bf16_t*)(zb1_ + zoff[k]); ZR[k][2] = (unsigned)*(const bf16_t*)(zb2_ + zoff[k]); } } while (0)
#define SCAN_BAR() do { LDS_WAIT(); __builtin_amdgcn_s_barrier(); asm volatile("" ::: "memory"); } while (0)
#define SCAN_PREP(CEXPR) do { const int c = (CEXPR); const bool do_prep = true; \
                if (do_prep) { \
                    const int tt0 = dir ? (T - 1 - ((c + 1) * TC + 4 * w4)) : ((c + 1) * TC + 4 * w4); \
                    LAS unsigned char* ibn = ibase + ((c + 1) & 1) * IB_BYTES; \
                    float cum = 0.f, cumq[4], eq[4]; \
_Pragma("unroll") \
                    for (int s = 0; s < 16; ++s) { const float ev = EF[s]; cum += ev; if ((s >> 2) == w4) { cumq[s & 3] = cum; eq[s & 3] = ev; } } \
                    float bt[4], kt[4], vt[4]; \
_Pragma("unroll") \
                    for (int q = 0; q < 4; ++q) { \
                        const int tp = tt0 + sgn * (q - 1), tn = tt0 + sgn * (q + 1); \
                        const bool okp = (tp >= 0 && tp < T), okn = (tn >= 0 && tn < T); \
                        const float rc = ZF[q + 1][0], kc = ZF[q + 1][1], vc = ZF[q + 1][2]; \
                        const float r_ = rc + mu_r * (0.5f * ((okp ? ZF[q][0] : 0.f) + (okn ? ZF[q + 2][0] : 0.f)) - rc); \
                        const float k_ = kc + mu_k * (0.5f * ((okp ? ZF[q][1] : 0.f) + (okn ? ZF[q + 2][1] : 0.f)) - kc); \
                        const float v_ = vc + mu_v * (0.5f * ((okp ? ZF[q][2] : 0.f) + (okn ? ZF[q + 2][2] : 0.f)) - vc); \
                        const float a_ = AF[q]; \
                        const float kk = k_ * kkc; \
                        const float kd = k_ * (1.0f + (a_ - 1.0f) * kac); \
                        const float ict = fexp(cumq[q]), ct = fexp(-cumq[q]), cprev = fexp(eq[q] - cumq[q]); \
                        const int ts = 4 * w4 + q; \
                        *(LAS bf16_t*)(ibn + OFF_AH + ts * SM_LD + F.lane * 2) = (bf16_t)(cvt_pk_bf16(-cprev * kk, 0.f) & 0xffffu); \
                        *(LAS bf16_t*)(ibn + OFF_RH + ts * SM_LD + F.lane * 2) = (bf16_t)(cvt_pk_bf16(ct * r_, 0.f) & 0xffffu); \
                        *(LAS bf16_t*)(ibn + OFF_PH + ts * SM_LD + F.lane * 2) = (bf16_t)(cvt_pk_bf16(kk, 0.f) & 0xffffu); \
                        *(LAS bf16_t*)(ibn + OFF_QH + ts * SM_LD + F.lane * 2) = (bf16_t)(cvt_pk_bf16(ct * r_ * rkc, 0.f) & 0xffffu); \
                        bt[q] = kk * a_ * ict; kt[q] = kd * ict; vt[q] = v_; \
                        *(LAS bf16_t*)(ibn + OFF_BH + ts * SM_LD + F.lane * 2) = (bf16_t)(cvt_pk_bf16(bt[q], 0.f) & 0xffffu); \
                        *(LAS bf16_t*)(ibn + OFF_KH + ts * SM_LD + F.lane * 2) = (bf16_t)(cvt_pk_bf16(kt[q], 0.f) & 0xffffu); \
                        if (ts == 15) *(LAS float*)(ibn + OFF_CL + F.lane * 4) = ct; \
                    } \
                    *(LAS u32x2*)(ibn + OFF_BT + F.lane * TR_LD + w4 * 8) = (u32x2){cvt_pk_bf16(bt[0], bt[1]), cvt_pk_bf16(bt[2], bt[3])}; \
                    *(LAS u32x2*)(ibn + OFF_KT + F.lane * TR_LD + w4 * 8) = (u32x2){cvt_pk_bf16(kt[0], kt[1]), cvt_pk_bf16(kt[2], kt[3])}; \
                    *(LAS u32x2*)(ibn + OFF_VT + F.lane * TR_LD + w4 * 8) = (u32x2){cvt_pk_bf16(vt[0], vt[1]), cvt_pk_bf16(vt[2], vt[3])}; \
                } \
            } while (0)
#define SCAN_RUN(CEXPR) do { const int c = (CEXPR); const bool do_run = true; \
                if (do_run) { \
                    const LAS unsigned char* ib = ibase + (c & 1) * IB_BYTES; \
                    bf16x8 Aop[2], Rop[2], Bop[2], Kop[2]; \
_Pragma("unroll") \
                    for (int kb = 0; kb < 2; ++kb) { const int o = fr * SM_LD + (32 * kb + 4 * fq) * 2; \
                        Aop[kb] = CAT8(*(const LAS bf16x4*)(ib + OFF_AH + o), *(const LAS bf16x4*)(ib + OFF_AH + o + 32)); \
                        Rop[kb] = CAT8(*(const LAS bf16x4*)(ib + OFF_RH + o), *(const LAS bf16x4*)(ib + OFF_RH + o + 32)); \
                        Bop[kb] = CAT8(*(const LAS bf16x4*)(ib + OFF_BH + o), *(const LAS bf16x4*)(ib + OFF_BH + o + 32)); \
                        Kop[kb] = CAT8(*(const LAS bf16x4*)(ib + OFF_KH + o), *(const LAS bf16x4*)(ib + OFF_KH + o + 32)); } \
                    f32x4 Dk = zero4, Db = zero4; \
_Pragma("unroll") \
                    for (int kb = 0; kb < 2; ++kb) { const int o = fr * SM_LD + (32 * kb + 4 * fq) * 2; \
                        const bf16x8 Pop = CAT8(*(const LAS bf16x4*)(ib + OFF_PH + o), *(const LAS bf16x4*)(ib + OFF_PH + o + 32)), Qop = CAT8(*(const LAS bf16x4*)(ib + OFF_QH + o), *(const LAS bf16x4*)(ib + OFF_QH + o + 32)); \
                        Dk = MFMA32(Pop, Pop, Dk); Db = MFMA32(Qop, Kop[kb], Db); } \
                    { const int e_ = fr & 3; const float dk = e_ == 0 ? Dk[0] : (e_ == 1 ? Dk[1] : (e_ == 2 ? Dk[2] : Dk[3])), db = e_ == 0 ? Db[0] : (e_ == 1 ? Db[1] : (e_ == 2 ? Db[2] : Db[3])); \
                      if (fq == (fr >> 2)) { rhoS[fr] = __builtin_amdgcn_rsqf(fmaxf(dk, L2_EPS)); \
                          if (w4 == 0) { const int st_ = c * TC + fr; SBd[(size_t)(s0 + (dir ? T - 1 - st_ : st_)) * NH + h] = db; } } } \
                    LDS_WAIT(); asm volatile("" ::: "memory"); \
                    const float rho_fr = rhoS[fr]; const f32x4 rho4 = *(const LAS f32x4*)(rhoS + 4 * fq); \
                    const bf16x4 v4 = *(const LAS bf16x4*)(ib + OFF_VT + (16 * w4 + fr) * TR_LD + fq * 8); \
                    f32x4 Nacc = zero4, Macc = zero4, NRacc = zero4, MRacc = zero4, NTacc = zero4; \
_Pragma("unroll") \
                    for (int kb = 0; kb < 2; ++kb) { Nacc = MFMA32(Bop[kb], Aop[kb], Nacc); Macc = MFMA32(Kop[kb], Aop[kb], Macc); NRacc = MFMA32(Bop[kb], Rop[kb], NRacc); \
                        MRacc = MFMA32(Kop[kb], Rop[kb], MRacc); NTacc = MFMA32(Aop[kb], Bop[kb], NTacc); } \
                    f32x4 Tm; \
_Pragma("unroll") \
                    for (int e = 0; e < 4; ++e) { const int m = 4 * fq + e; \
                        Nacc[e] = m < fr ? Nacc[e] * (rho4[e] * rho_fr) : 0.f; Macc[e] = m < fr ? Macc[e] * rho_fr : 0.f; NRacc[e] = m <= fr ? NRacc[e] : 0.f; MRacc[e] = m <= fr ? MRacc[e] : 0.f; NTacc[e] = fr < m ? NTacc[e] * (rho4[e] * rho_fr) : 0.f; \
                        Tm[e] = Nacc[e] + (m == fr ? 1.f : 0.f); } \
                    const bf16x4 n4 = CVT4(Nacc), nt4 = CVT4(NTacc); \
                    const f32x4 P1 = MFMA16(nt4, n4, zero4), P1T = MFMA16(n4, nt4, zero4); \
                    const bf16x4 p1 = CVT4(P1), p1t = CVT4(P1T); \
                    Tm = MFMA16(p1t, CVT4(Tm), Tm); \
                    const f32x4 P2 = MFMA16(p1t, p1, zero4), P2T = MFMA16(p1, p1t, zero4); \
                    const bf16x4 p2 = CVT4(P2), p2t = CVT4(P2T); \
                    Tm = MFMA16(p2t, CVT4(Tm), Tm); \
                    const f32x4 P3T = MFMA16(p2, p2t, zero4); \
                    Tm = MFMA16(CVT4(P3T), CVT4(Tm), Tm); \
                    bf16x8 Sop[2]; \
_Pragma("unroll") \
                    for (int kb = 0; kb < 2; ++kb) Sop[kb] = CAT8(CVT4(S[2 * kb]), CVT4(S[2 * kb + 1])); \
                    f32x4 X = zero4, YR = zero4; \
_Pragma("unroll") \
                    for (int kb = 0; kb < 2; ++kb) { X = MFMA32(Aop[kb], Sop[kb], X); YR = MFMA32(Rop[kb], Sop[kb], YR); } \
                    const f32x4 W1 = MFMA16(CVT4(Macc), v4, X * rho4); \
                    const f32x4 U = MFMA16(CVT4(Tm), CVT4(W1), zero4) * rho4; \
                    const bf16x8 uv = CAT8(CVT4(U), v4); \
                    const f32x4 Y = MFMA32(CAT8(CVT4(NRacc), CVT4(MRacc)), uv, YR); \
_Pragma("unroll") \
                    for (int jt = 0; jt < 4; ++jt) { const int j = 16 * jt + fr; \
                        const bf16x8 bk = CAT8(*(const LAS bf16x4*)(ib + OFF_BT + j * TR_LD + fq * 8), *(const LAS bf16x4*)(ib + OFF_KT + j * TR_LD + fq * 8)); \
                        S[jt] = MFMA32(bk, uv, S[jt]); \
                        S[jt] = S[jt] * *(const LAS f32x4*)(ib + OFF_CL + (16 * jt + 4 * fq) * 4); } \
                    LAS bf16_t* yb = ybase + (c & 1) * (TC * 64); \
_Pragma("unroll") \
                    for (int e = 0; e < 4; ++e) yb[(4 * fq + e) * 64 + 16 * w4 + fr] = (bf16_t)(cvt_pk_bf16(Y[e], 0.f) & 0xffffu); \
                } \
            } while (0)
#define SCAN_FLUSH(CEXPR) do { const int c = (CEXPR); const bool do_run = true; \
                if (do_run) { \
                    const LAS bf16_t* yb = ybase + (c & 1) * (TC * 64); \
_Pragma("unroll") \
                    for (int q = 0; q < 4; ++q) { const int st = c * TC + 4 * w4 + q; const int t = dir ? (T - 1 - st) : st; \
                        Yd[(size_t)(s0 + t) * 2048 + ch] = yb[(4 * w4 + q) * 64 + F.lane]; } \
                } \
            } while (0)
            if (role == 1) {
                unsigned er[16], ar[4], zr[6][3];
                SCAN_ISSUE(0, er, ar, zr);
                const int kbase = item ? 256 : 0;
#define ABS_ROW(k) (min(arow0 + min((k), 372), DM - 1))
                f32x4 wq = *(const f32x4*)(wabs + (size_t)ABS_ROW(kbase) * NUP); float gq = nfa[ABS_ROW(kbase)];
                for (int cp = -1; cp < nch - 1; ++cp) {
                    float EF[16], AF[4], ZF[6][3];
#pragma unroll
                    for (int s = 0; s < 16; ++s) EF[s] = bf2f((bf16_t)er[s]);
#pragma unroll
                    for (int q = 0; q < 4; ++q) AF[q] = bf2f((bf16_t)ar[q]);
#pragma unroll
                    for (int k = 0; k < 6; ++k) { ZF[k][0] = bf2f((bf16_t)zr[k][0]); ZF[k][1] = bf2f((bf16_t)zr[k][1]); ZF[k][2] = bf2f((bf16_t)zr[k][2]); }
                    asm volatile("" : "+v"(EF[0]), "+v"(EF[1]), "+v"(EF[2]), "+v"(EF[3]), "+v"(EF[4]), "+v"(EF[5]), "+v"(EF[6]), "+v"(EF[7]), "+v"(EF[8]), "+v"(EF[9]), "+v"(EF[10]), "+v"(EF[11]),
                                 "+v"(EF[12]), "+v"(EF[13]), "+v"(EF[14]), "+v"(EF[15]), "+v"(AF[0]), "+v"(AF[1]), "+v"(AF[2]), "+v"(AF[3]) :: "memory");
                    asm volatile("" : "+v"(ZF[0][0]), "+v"(ZF[0][1]), "+v"(ZF[0][2]), "+v"(ZF[1][0]), "+v"(ZF[1][1]), "+v"(ZF[1][2]), "+v"(ZF[2][0]), "+v"(ZF[2][1]), "+v"(ZF[2][2]),
                                 "+v"(ZF[3][0]), "+v"(ZF[3][1]), "+v"(ZF[3][2]), "+v"(ZF[4][0]), "+v"(ZF[4][1]), "+v"(ZF[4][2]), "+v"(ZF[5][0]), "+v"(ZF[5][1]), "+v"(ZF[5][2]) :: "memory");
                    f32x4 wc = wq; float g_ = gq; asm volatile("" : "+v"(wc), "+v"(g_));
                    SCAN_ISSUE(cp + 2, er, ar, zr);
                    { const int rn_ = ABS_ROW(kbase + cp + 2); wq = *(const f32x4*)(wabs + (size_t)rn_ * NUP); gq = nfa[rn_];
                      const unsigned b0 = __builtin_bit_cast(unsigned, wc[0] * g_) & 0x7fffffffu, b1 = __builtin_bit_cast(unsigned, wc[1] * g_) & 0x7fffffffu, b2 = __builtin_bit_cast(unsigned, wc[2] * g_) & 0x7fffffffu, b3 = __builtin_bit_cast(unsigned, wc[3] * g_) & 0x7fffffffu;
                      am0 = b0 > am0 ? b0 : am0; am1 = b1 > am1 ? b1 : am1; am2 = b2 > am2 ? b2 : am2; am3 = b3 > am3 ? b3 : am3; }
                    SCAN_PREP(cp);
                    SCAN_BAR();
                }
#undef ABS_ROW
                SCAN_BAR(); SCAN_BAR();
            } else {
                SCAN_BAR();
                for (int c2 = 0; c2 < nch; ++c2) { SCAN_RUN(c2); SCAN_BAR(); SCAN_FLUSH(c2); }
                SCAN_BAR();
            }
#undef SCAN_ISSUE
#undef SCAN_BAR
#undef SCAN_PREP
#undef SCAN_RUN
#undef SCAN_FLUSH
            __syncthreads();
        }
        if (role == 1 && abs_in_scan) { unsigned* dst = (unsigned*)(ctl + CW_WMAX) + 256 * acb + 4 * F.lane; atomicMax(dst + 0, am0); atomicMax(dst + 1, am1); atomicMax(dst + 2, am2); atomicMax(dst + 3, am3); }
#undef CVT4
#undef CAT8
#undef MFMA32
#undef MFMA16
        SEAM(4);
    }
    if (IN(5)) {
        {
            pg8::SchedGrid S{(const char*)A_gate, (const char*)Wt_gate, 512, 512, MTOK / 256, 8, F.G, F.bid};
            pg8::EpiGate E{CAT, YF, ZH + (size_t)64 * MTOK * 64, SBN, ARGIN(I_GNG), ARGIN(I_GNB), ARGIN(I_MU) + 4096, xs};
            pg8::gemm_phase<pg8::EpiGate, pg8::SchedGrid, true, true>(F.lds, 512, 512, 512, S, E);
        }
        __syncthreads();
        {
            constexpr int WS_LD = 136;
            LAS bf16_t* Wl = (LAS bf16_t*)F.lds;
            LAS bf16_t* Vt = (LAS bf16_t*)(F.lds + 128 * WS_LD * 2);
            LAS float* st = (LAS float*)(F.lds + 128 * WS_LD * 2 + 256 * WS_LD * 2);
            const float* lnst = (const float*)(ctl + CW_LN);
            const int fr = F.lane & 15, fq = F.lane >> 4;
            for (int it = F.bid; it < 192 * 4; it += F.G) {
                const int ck = it >> 2, h = it & 3, t0 = ck * 128;
                if (F.tid < 128) { const float s1 = lnst[2 * (t0 + F.tid)], s2 = lnst[2 * (t0 + F.tid) + 1];
                    const float mean = s1 * (1.f / 2048.f), var = fmaxf(s2 * (1.f / 2048.f) - mean * mean, 0.f);
                    st[2 * F.tid] = mean; st[2 * F.tid + 1] = __builtin_amdgcn_rsqf(var + LN_EPS); }
                { const float* wsrc = ARGIN(I_WS) + (size_t)h * 128 * 128;
                  for (int i = F.tid; i < 128 * 128 / 4; i += 512) { const f32x4 v = ((const f32x4*)wsrc)[i]; const int p = (4 * i) >> 7, q = (4 * i) & 127;
                      u32x2 w; w.x = cvt_pk_bf16(v[0], v[1]); w.y = cvt_pk_bf16(v[2], v[3]); *(LAS u32x2*)(Wl + p * WS_LD + q) = w; } }
                LDS_WAIT(); __syncthreads();
                for (int db = 0; db < 2; ++db) {
                    const int d0 = h * 512 + db * 256;
                    const int oct = F.lane & 7, qp = F.lane >> 3;
                    for (int wi = F.wave; wi < 32; wi += 8) {
                        const int qb = (wi >> 2) * 16, cb = (wi & 3) * 64, q = qb + 2 * qp, dl = cb + 8 * oct;
                        const bf16_t* vp = ZA + (size_t)(t0 + q) * DM + 2048 + d0 + dl;
                        float a[8], b[8]; unpack8(*(const u32x4*)vp, a); unpack8(*(const u32x4*)(vp + DM), b);
                        const float m0 = st[2 * q], r0 = st[2 * q + 1], m1 = st[2 * q + 2], r1 = st[2 * q + 3];
                        const f32x4 lg0 = *(const f32x4*)(ARGIN(I_LNG) + d0 + dl), lg1 = *(const f32x4*)(ARGIN(I_LNG) + d0 + dl + 4), lb0 = *(const f32x4*)(ARGIN(I_LNB) + d0 + dl), lb1 = *(const f32x4*)(ARGIN(I_LNB) + d0 + dl + 4);
#pragma unroll
                        for (int e = 0; e < 8; ++e) { const float g_ = e < 4 ? lg0[e & 3] : lg1[e & 3], b_ = e < 4 ? lb0[e & 3] : lb1[e & 3];
                            const int d = dl + e, slot = (d & ~31) + 16 * ((d >> 2) & 1) + 4 * ((d >> 3) & 3) + (d & 3);
                            *(LAS unsigned*)(Vt + slot * WS_LD + q) = cvt_pk_bf16((a[e] - m0) * r0 * g_ + b_, (b[e] - m1) * r1 * g_ + b_); }
                    }
                    LDS_WAIT(); __syncthreads();
                    f32x4 acc[8][2];
#pragma unroll
                    for (int pt = 0; pt < 8; ++pt) { acc[pt][0] = (f32x4){0.f, 0.f, 0.f, 0.f}; acc[pt][1] = (f32x4){0.f, 0.f, 0.f, 0.f}; }
#pragma unroll
                    for (int ks = 0; ks < 4; ++ks) {
                        bf16x8 bfr[2];
#pragma unroll
                        for (int dt = 0; dt < 2; ++dt) bfr[dt] = *(const LAS bf16x8*)(Vt + (32 * F.wave + 16 * dt + fr) * WS_LD + 32 * ks + 8 * fq);
#pragma unroll
                        for (int pt = 0; pt < 8; ++pt) { const bf16x8 afr = *(const LAS bf16x8*)(Wl + (16 * pt + fr) * WS_LD + 32 * ks + 8 * fq);
                            acc[pt][0] = __builtin_amdgcn_mfma_f32_16x16x32_bf16(bfr[0], afr, acc[pt][0], 0, 0, 0);
                            acc[pt][1] = __builtin_amdgcn_mfma_f32_16x16x32_bf16(bfr[1], afr, acc[pt][1], 0, 0, 0); }
                    }
#pragma unroll
                    for (int pt = 0; pt < 8; ++pt) { const int p = 16 * pt + fr; const float bs = ARGIN(I_BS)[h * 128 + p];
                        const int col = d0 + 32 * F.wave + 8 * fq;
                        float uu[8]; unpack8(*(const u32x4*)(ZA + (size_t)(t0 + p) * DM + col), uu);
                        float o[8];
#pragma unroll
                        for (int e = 0; e < 4; ++e) { o[e] = uu[e] * (acc[pt][0][e] + bs); o[4 + e] = uu[4 + e] * (acc[pt][1][e] + bs); }
                        *(u32x4*)(CAT + (size_t)(t0 + p) * DM + col) = pack8(o); }
                    __syncthreads();
                }
            }
        }
        SEAM(5);
    }
    if (IN(6)) { }
    if (IN(7)) {
        pg8::SchedGrid S{(const char*)CAT, (const char*)Wt_out, DM, DM, MTOK / 256, DM / 256, F.G, F.bid};
        pg8::EpiRes E{ARGIN(I_XP), ARGIN(I_XS), X1B, rep ? ssd : ss1};
        pg8::gemm_phase<pg8::EpiRes, pg8::SchedGrid, true, true>(F.lds, DM, DM, DM, S, E);
        {
            pg8::SchedGrid S2{(const char*)memn, (const char*)Wt_kv, DM, DM, 2048 / 256, 2 * DM / 256, F.G, F.bid};
            pg8::EpiBf16<0> E2{KVB, 2 * DM, nullptr, nullptr, nullptr, nullptr, nullptr};
            pg8::gemm_phase<pg8::EpiBf16<0>, pg8::SchedGrid, true, true>(F.lds, DM, DM, DM, S2, E2); }
        SEAM(7);
    }
    if (IN(8)) {
        struct SchedKW { const char* KV; const char* WQ; int G, c;
            __device__ __forceinline__ bool next(int i, pg8::Unit& u) const {
                const long L = (long)i * G + c; if (L >= 512) return false;
                const int b = (int)L >> 6, r = (int)L & 63, h = r >> 4, pn = r & 15; u.pm = b * 4 + h; u.pn = pn; u.z = 0; u.pad = 0;
                u.A = KV + ((size_t)(b * 256) * (2 * DM) + h * 1024) * 2; u.B = WQ + ((size_t)(pn * 256) * DM + h * 1024) * 2; return true; } };
        SchedKW S{(const char*)KVB, (const char*)WQR, F.G, F.bid};
        pg8::EpiBf16<0> E{KWt, DM, nullptr, nullptr, nullptr, nullptr, nullptr};
        pg8::gemm_phase<pg8::EpiBf16<0>, SchedKW, true, true>(F.lds, 1024, 2 * DM, DM, S, E);
        {
            struct SchedVW { const char* WO; const char* KV; int G, c;
                __device__ __forceinline__ bool next(int i, pg8::Unit& u) const {
                    if (c < 0) return false;
                    const long L = (long)i * G + c; if (L >= 512) return false;
                    const int b = (int)L >> 6, r = (int)L & 63, pm = r >> 2, h = r & 3; u.pm = b * 16 + pm; u.pn = h; u.z = 0; u.pad = 0;
                    u.A = WO + ((size_t)(pm * 256) * DM + h * 1024) * 2; u.B = KV + ((size_t)(b * 256) * (2 * DM) + DM + h * 1024) * 2; return true; } };
            SchedVW S{(const char*)Wt_o, (const char*)KVB, F.G, F.bid};
            pg8::EpiBf16<0> E{VWt, 1024, nullptr, nullptr, nullptr, nullptr, nullptr};
            pg8::gemm_phase<pg8::EpiBf16<0>, SchedVW, true, true>(F.lds, 1024, DM, 2 * DM, S, E); }
        SEAM(8);
    }
    if (IN(9)) {
        {   struct SchedS { const char* X; const char* KW; int G, c;
                __device__ __forceinline__ bool next(int i, pg8::Unit& u) const {
                    const long L = (long)i * G + c; if (L >= 384) return false;
                    u.pm = (int)L >> 2; u.pn = (int)L & 3; const int b = seq_of_row(u.pm * 256); u.z = b; u.pad = 0;
                    u.A = X + (size_t)u.pm * 256 * DM * 2; u.B = KW + ((size_t)(b * 1024 + u.pn * 256) * DM) * 2; return true; } };
            SchedS S{(const char*)X1B, (const char*)KWt, F.G, F.bid};
            pg8::EpiSoftmax E{PB, xs, ss1};
            pg8::gemm_phase<pg8::EpiSoftmax, SchedS, true, true>(F.lds, DM, DM, DM, S, E); }
        {
            const int n2 = (384 > F.G && 384 <= 2 * F.G) ? 384 - F.G : 0;
            if (n2 && F.bid >= n2) { LAS float* scr = (LAS float*)(F.lds + F.wave * 16384);
                convert_items_i8(ARGIN(I_WUP), DM, NUP, WupQ, ARGIN(I_NFFN), wmaxf, scr, (F.bid - n2) * NWAVES + F.wave, UP_EARLY_ITEMS, (F.G - n2) * NWAVES, F.lane); } }
        SEAM(9);
    }
    if (IN(10)) { }
    if (IN(11)) {
        struct SchedA { const char* P; const char* VW; int G, c;
            __device__ __forceinline__ bool next(int i, pg8::Unit& u) const {
                const long L = (long)i * G + c; if (L >= 1536) return false;
                pg8::tile_order((int)L, 96, 16, u.pm, u.pn); const int b = seq_of_row(u.pm * 256); u.z = b; u.pad = 0;
                u.A = P + (size_t)u.pm * 256 * 1024 * 2; u.B = VW + ((size_t)(b * 4096 + u.pn * 256) * 1024) * 2; return true; } };
        SchedA S{(const char*)PB, (const char*)VWt, F.G, F.bid};
        pg8::EpiRes E{nullptr, nullptr, rep ? (bf16_t*)(ws + WS_Z + 256 * MiB) : X1B, rep ? ssd : ss2};
        pg8::gemm_phase<pg8::EpiRes, SchedA, true, true>(F.lds, 1024, 1024, 1024, S, E);
        if (!rep) {
            LAS float* scr = (LAS float*)(F.lds + F.wave * 16384);
            constexpr int I_UP = 64 * (NUP / 32);
            const int early = (384 > F.G && 384 <= 2 * F.G) ? UP_EARLY_ITEMS : 0;
            convert_items_i8(ARGIN(I_WUP), DM, NUP, WupQ, ARGIN(I_NFFN), wmaxf, scr, early + gw, I_UP, NGW, F.lane); }
        SEAM(11);
    }
    if (IN(12)) {
        for (int row = gw; row < MTOK; row += NGW) {
            const u32x4* xr = (const u32x4*)(X1B + (size_t)row * DM);
            const int prow = (row & ~63) + 16 * (row & 3) + ((row >> 2) & 15);
            float f[8][8]; float mx = 0.f;
#pragma unroll
            for (int j = 0; j < 8; ++j) { unpack8(xr[F.lane + 64 * j], f[j]);
#pragma unroll
                for (int e = 0; e < 8; ++e) mx = fmaxf(mx, fabsf(f[j][e])); }
#pragma unroll
            for (int o = 1; o < 64; o <<= 1) mx = fmaxf(mx, __shfl_xor(mx, o));
            mx = fmaxf(mx, 1e-30f);
            const float iq = 127.0f * __builtin_amdgcn_rcpf(mx);
#pragma unroll
            for (int j = 0; j < 8; ++j) { u32x2 o; o.x = pack4_i8(f[j][0] * iq, f[j][1] * iq, f[j][2] * iq, f[j][3] * iq); o.y = pack4_i8(f[j][4] * iq, f[j][5] * iq, f[j][6] * iq, f[j][7] * iq);
                ((u32x2*)(X2Q + (size_t)prow * DM))[F.lane + 64 * j] = o; }
            if (F.lane == 0) zsc[row] = __builtin_amdgcn_rsqf(ss2[row] * (1.0f / DM) + RMS_EPS) * (mx * (1.0f / 127.0f));
        }
        SEAM(12);
    }
    if (IN(13)) {
        pg8::SchedGrid S{(const char*)X2Q, (const char*)WupQ, DM / 2, DM / 2, MTOK / 256, NUP / 256, F.G, F.bid};
        pg8::EpiUp E{ACT, ZBf, zsc, wmaxf, ARGIN(I_CW), ARGIN(I_CB), xs};
        pg8::gemm_phase<pg8::EpiUp, pg8::SchedGrid, true, true, true>(F.lds, DM / 2, DM / 2, DM / 2, S, E);
        {
            const int nun = (MTOK / 256) * (NUP / 256), rounds = (nun + F.G - 1) / F.G, nbusy = nun - (rounds - 1) * F.G, nidle = F.G - nbusy;
            LAS float* scr = (LAS float*)(F.lds + F.wave * 16384);
            constexpr int I_DN = (DFF / 64) * (DM / 32);
            const int w0 = (nidle > 0) ? ((F.bid - nbusy) * NWAVES + F.wave) : gw, nw = (nidle > 0) ? nidle * NWAVES : NGW;
            if (nidle == 0 || F.bid >= nbusy) convert_items<0>(ARGIN(I_WDOWN), DFF, DM, Wt_down, nullptr, scr, w0, I_DN, nw, F.lane);
        }
        SEAM(13);
    }
    if (IN(14)) {
        const float* cw = ARGIN(I_CW); const float* cb = ARGIN(I_CB);
        for (int it = F.bid * 512 + F.tid; it < 96 * 2 * (DFF / 4); it += F.G * 512) {
            const int oq = it % (DFF / 4), pe = it / (DFF / 4), pm = pe >> 1, e = pe & 1;
            const int row = pm * 256 + (e ? 255 : 0), s0 = seq_start_of_row(row), T = seq_len_of_row(row), t = row - s0;
            const bool okp = e ? true : (t > 0), okn = e ? (t < T - 1) : true;
            const float* zc = ZBf + ((size_t)pm * 4 + (e ? 3 : 0)) * NUP;
            const float* zp = e ? ZBf + ((size_t)pm * 4 + 2) * NUP : (okp ? ZBf + ((size_t)(pm - 1) * 4 + 3) * NUP : zc);
            const float* zn = e ? (okn ? ZBf + ((size_t)(pm + 1) * 4 + 0) * NUP : zc) : ZBf + ((size_t)pm * 4 + 1) * NUP;
            f32x4 cz[2];
#pragma unroll
            for (int bj = 0; bj < 2; ++bj) { const int cc = bj * DFF + 4 * oq;
                f32x4 p_ = *(const f32x4*)(zp + cc), n_ = *(const f32x4*)(zn + cc); const f32x4 c_ = *(const f32x4*)(zc + cc);
                if (!okp) p_ = (f32x4){0.f, 0.f, 0.f, 0.f}; if (!okn) n_ = (f32x4){0.f, 0.f, 0.f, 0.f};
                cz[bj] = *(const f32x4*)(cw + cc) * p_ + *(const f32x4*)(cw + NUP + cc) * c_ + *(const f32x4*)(cw + 2 * NUP + cc) * n_ + *(const f32x4*)(cb + cc); }
            float o[4];
#pragma unroll
            for (int j = 0; j < 4; ++j) o[j] = cz[0][j] * sigmoidf_(cz[0][j]) * cz[1][j];
            *(u32x2*)(ACT + (size_t)row * DFF + 4 * oq) = (u32x2){cvt_pk_bf16(o[0], o[1]), cvt_pk_bf16(o[2], o[3])};
        }
        SEAM(14);
    }
    if (IN(15)) {
        pg8::SchedGrid S{(const char*)ACT, (const char*)Wt_down, DFF, DFF, MTOK / 256, DM / 256, F.G, F.bid};
        pg8::EpiRes E{nullptr, nullptr, rep ? (bf16_t*)(ws + WS_Z + 256 * MiB) : X1B, rep ? ssd : ss3};
        pg8::gemm_phase<pg8::EpiRes, pg8::SchedGrid, true, true>(F.lds, DFF, DFF, DFF, S, E);
        SEAM(15);
    }
    if (IN(16)) {
        const float* g = ARGIN(I_NOUT);
        for (int row = gw; row < MTOK; row += NGW) {
            const float rs = __builtin_amdgcn_rsqf(ss3[row] * (1.f / DM) + RMS_EPS);
            const u32x4* xr = (const u32x4*)(X1B + (size_t)row * DM); f32x4* yr = (f32x4*)(ARG_OUT + (size_t)row * DM);
#pragma unroll 4
            for (int j = 0; j < 8; ++j) { float f[8]; unpack8(xr[F.lane + 64 * j], f); const f32x4 g0 = ((const f32x4*)g)[2 * (F.lane + 64 * j)], g1 = ((const f32x4*)g)[2 * (F.lane + 64 * j) + 1];
                yr[2 * (F.lane + 64 * j)] = (f32x4){f[0], f[1], f[2], f[3]} * rs * g0; yr[2 * (F.lane + 64 * j) + 1] = (f32x4){f[4], f[5], f[6], f[7]} * rs * g1; }
        }
    }
#undef IN
#undef SEAM
}

#ifndef MK_SINGLE
#define MK_SINGLE 1
#endif
extern "C" void kernel_launch(void* const* d_in, const int* in_sizes, int n_in, void* d_out, int out_size, void* d_ws, size_t ws_size, hipStream_t stream) {
    static int grid = 0;
    if (grid == 0) {
        if (n_in != 33 || out_size != MTOK * DM || ws_size < WS_END) { fprintf(stderr, "kernel_launch: unexpected shapes (n_in %d out %d ws %zu, need %zu)\n", n_in, out_size, ws_size, (size_t)WS_END); grid = -1; return; }
        int dev = 0, cus = 0, per_cu = 0;
        if (hipGetDevice(&dev) != hipSuccess || hipDeviceGetAttribute(&cus, hipDeviceAttributeMultiprocessorCount, dev) != hipSuccess) { grid = -1; return; }
        if (hipFuncSetAttribute((const void*)fwd, hipFuncAttributeMaxDynamicSharedMemorySize, LDS_BYTES) != hipSuccess) { fprintf(stderr, "kernel_launch: hipFuncSetAttribute failed\n"); grid = -1; return; }
        if (hipOccupancyMaxActiveBlocksPerMultiprocessor(&per_cu, (const void*)fwd, NWAVES * 64, LDS_BYTES) != hipSuccess || per_cu < 1) fprintf(stderr, "kernel_launch: occupancy query says %d\n", per_cu);
        (void)hipGetLastError();
        grid = cus;
    }
    if (grid < 0) return;
    (void)hipMemsetAsync((char*)d_ws + WS_CTL, 0, CTL_ZERO_BYTES, stream);
    Args a{};
    for (int i = 0; i < 33; ++i) a.in[i] = (const float*)d_in[i];
    a.out = (float*)d_out; a.ws = (unsigned char*)d_ws;
#if MK_SINGLE
    a.ph_lo = 0; a.ph_hi = NPH + 1;
    hipLaunchKernelGGL(fwd, dim3(grid), dim3(NWAVES * 64), LDS_BYTES, stream, a);
#else
    for (int p = 0; p <= NPH; ++p) { a.ph_lo = p; a.ph_hi = p + 1; a.rep = 0; hipLaunchKernelGGL(fwd, dim3(grid), dim3(NWAVES * 64), LDS_BYTES, stream, a);
#ifdef PROBE_MASK2
        if (((PROBE_MASK2) >> p) & 1) { a.rep = 1; hipLaunchKernelGGL(fwd, dim3(grid), dim3(NWAVES * 64), LDS_BYTES, stream, a); }
#endif
    }
#endif
}
```

```cpp
#include <hip/hip_runtime.h>
#include <cstdio>
#include <cstdint>

#ifndef I8_LO
#define I8_LO 16
#define I8_HI 40
#endif
#define GAS __attribute__((address_space(1)))
#define LAS __attribute__((address_space(3)))
typedef unsigned short bf16_t;
typedef short bf16x8 __attribute__((ext_vector_type(8)));
typedef float f32x4 __attribute__((ext_vector_type(4)));
typedef float f32x2 __attribute__((ext_vector_type(2)));
typedef unsigned u32x4 __attribute__((ext_vector_type(4)));
typedef unsigned u32x2 __attribute__((ext_vector_type(2)));
typedef int i32x4 __attribute__((ext_vector_type(4)));

constexpr int DM = 4096, MTOK = 24576, NTP = 16384;
constexpr int INC = 11008, DFF = 11008, NUP = 22016;
constexpr int ZB0 = 4096;
constexpr int NH = 32;
constexpr float RMS_EPS = 1e-6f, LN_EPS = 1e-5f, GN_EPS = 64e-5f, L2_EPS = 1e-12f;
constexpr int NPH = 16;
constexpr int UP_EARLY_ITEMS = (64 * (NUP / 32)) * 6 / 8;

constexpr size_t MiB = 1u << 20;
constexpr size_t WS_CTL = 0, CTL_ZERO_BYTES = 1 * MiB;
constexpr size_t WS_WIN = 2 * MiB;
constexpr size_t WS_WOUT = WS_WIN + 86 * MiB;
constexpr size_t WS_WQ = WS_WOUT + 32 * MiB;
constexpr size_t WS_WKV = WS_WQ + 32 * MiB;
constexpr size_t WS_WO = WS_WKV + 64 * MiB;
constexpr size_t WS_WGATE = WS_WO + 32 * MiB;
constexpr size_t WS_WLORA = WS_WGATE + 2 * MiB;
constexpr size_t WS_ALORA = WS_WLORA + 4 * MiB;
constexpr size_t WS_AGATE = WS_ALORA + 12 * MiB;
constexpr size_t WS_ZB = WS_ALORA;
constexpr size_t WS_MEMN = WS_AGATE + 24 * MiB;
constexpr size_t WS_KB = WS_MEMN + 16 * MiB;
constexpr size_t WS_VT = WS_KB + 16 * MiB;
constexpr size_t WS_SB = WS_VT + 16 * MiB;
constexpr size_t WS_H = WS_SB + 6 * MiB;
constexpr size_t WS_C = WS_H + 192 * MiB;
constexpr size_t WS_G = WS_C + 192 * MiB;
constexpr size_t WS_Z = WS_G + 96 * MiB;
constexpr size_t WS_END = WS_Z + 516 * MiB;
static_assert(WS_END <= (size_t)1400 * MiB, "workspace map");
constexpr int CW_BAR = 4096;
constexpr int CW_SS = 16384;
constexpr int CW_LN = CW_SS + 4 * MTOK;
constexpr int CW_ZS = CW_LN + 2 * MTOK;
constexpr int CW_WMAX = CW_ZS + MTOK;
constexpr int CW_RS0 = CW_WMAX + NUP;
constexpr int CW_WMIN = CW_RS0 + MTOK;
static_assert((CW_WMIN + 6144) * 4 <= (int)CTL_ZERO_BYTES, "ctl");

constexpr int RING_BYTES = 131072;
constexpr int XS_OFF = RING_BYTES;
constexpr int MISC_OFF = XS_OFF + 16384;
constexpr int LDS_BYTES = MISC_OFF + 256;
static_assert(LDS_BYTES <= 163840, "LDS");

#define RLX_AGENT __ATOMIC_RELAXED, __HIP_MEMORY_SCOPE_AGENT
#define LDS_WAIT() asm volatile("s_waitcnt lgkmcnt(0)" ::: "memory")
#define VM_WAIT() asm volatile("s_waitcnt vmcnt(0)" ::: "memory")
typedef __bf16 bf16x2v __attribute__((ext_vector_type(2)));
__device__ __forceinline__ unsigned cvt_pk_bf16(float lo, float hi) { return __builtin_bit_cast(unsigned, __builtin_convertvector((f32x2){lo, hi}, bf16x2v)); }
__device__ __forceinline__ float bflo(unsigned u) { return __builtin_bit_cast(float, u << 16); }
__device__ __forceinline__ float bfhi(unsigned u) { return __builtin_bit_cast(float, u & 0xffff0000u); }
__device__ __forceinline__ float bf2f(bf16_t b) { return __builtin_bit_cast(float, ((unsigned)b) << 16); }
__device__ __forceinline__ float fexp(float x) { return __builtin_amdgcn_exp2f(x * 1.4426950408889634f); }
__device__ __forceinline__ float frcp(float x) { return __builtin_amdgcn_rcpf(x); }
__device__ __forceinline__ float sigmoidf_(float x) { return frcp(1.0f + fexp(-x)); }
__device__ __forceinline__ float tanhf_(float x) { return 2.0f * sigmoidf_(2.0f * x) - 1.0f; }
__device__ __forceinline__ float gelu_tanh(float x) { const float u = 0.7978845608028654f * (x + 0.044715f * x * x * x); return x * sigmoidf_(2.0f * u); }
__device__ __forceinline__ f32x4 gelu_tanh4(const f32x4 x) {
    const float C1 = -2.0f * 0.7978845608028654f * 1.4426950408889634f, C2 = C1 * 0.044715f;
    const f32x4 t = x * (x * x * C2 + C1); f32x4 r;
#pragma unroll
    for (int j = 0; j < 4; ++j) r[j] = frcp(1.0f + __builtin_amdgcn_exp2f(t[j]));
    return x * r;
}
__device__ __forceinline__ f32x4 sigmoid_bias4(const f32x4 v, const f32x4 nb, const float sc) {
    const f32x4 t = v * -1.4426950408889634f + nb; f32x4 r;
#pragma unroll
    for (int j = 0; j < 4; ++j) r[j] = frcp(1.0f + __builtin_amdgcn_exp2f(t[j]));
    return r * sc;
}
__device__ __forceinline__ float wave_sum(float v) {
#pragma unroll
    for (int o = 1; o < 64; o <<= 1) v += __shfl_xor(v, o);
    return v;
}
#define DPPF(x, ctrl) __builtin_bit_cast(float, __builtin_amdgcn_update_dpp(0, __builtin_bit_cast(int, (x)), (ctrl), 0xF, 0xF, false))
__device__ __forceinline__ float wave_sum_dpp(float x) {
    x += DPPF(x, 0xB1); x += DPPF(x, 0x4E); x += DPPF(x, 0x141); x += DPPF(x, 0x140);
    const int xi = __builtin_bit_cast(int, x);
    const float a = __builtin_bit_cast(float, __builtin_amdgcn_readlane(xi, 0)), b = __builtin_bit_cast(float, __builtin_amdgcn_readlane(xi, 16));
    const float c = __builtin_bit_cast(float, __builtin_amdgcn_readlane(xi, 32)), d = __builtin_bit_cast(float, __builtin_amdgcn_readlane(xi, 48));
    return (a + b) + (c + d);
}
__device__ __forceinline__ float red8(float x) {
    x += __builtin_bit_cast(float, __builtin_amdgcn_update_dpp(0, __builtin_bit_cast(int, x), 0xB1, 0xF, 0xF, false));
    x += __builtin_bit_cast(float, __builtin_amdgcn_update_dpp(0, __builtin_bit_cast(int, x), 0x4E, 0xF, 0xF, false));
    x += __builtin_bit_cast(float, __builtin_amdgcn_update_dpp(0, __builtin_bit_cast(int, x), 0x141, 0xF, 0xF, false));
    return x;
}
__device__ __forceinline__ void unpack8(const u32x4 w, float (&f)[8]) { f[0] = bflo(w.x); f[1] = bfhi(w.x); f[2] = bflo(w.y); f[3] = bfhi(w.y); f[4] = bflo(w.z); f[5] = bfhi(w.z); f[6] = bflo(w.w); f[7] = bfhi(w.w); }
__device__ __forceinline__ u32x4 pack8(const float (&f)[8]) { u32x4 w; w.x = cvt_pk_bf16(f[0], f[1]); w.y = cvt_pk_bf16(f[2], f[3]); w.z = cvt_pk_bf16(f[4], f[5]); w.w = cvt_pk_bf16(f[6], f[7]); return w; }
__device__ __forceinline__ int seq_len_of_row(int row) { return row < NTP ? 4096 : 2048; }
__device__ __forceinline__ int seq_start_of_row(int row) { return row < NTP ? (row & ~4095) : (NTP + ((row - NTP) & ~2047)); }
__device__ __forceinline__ int seq_of_row(int row) { return row < NTP ? (row >> 12) : 4 + ((row - NTP) >> 11); }
__device__ __forceinline__ int seq_start(int s) { return s < 4 ? s * 4096 : NTP + (s - 4) * 2048; }

#define XB_TMO      128
#define XB_XCNT(j)  (256  + 64 * (j))
#define XB_XSUB(j)  (1280 + 64 * (j))
#define XB_XGEN(j)  (2304 + 64 * (j))
#define XB_TOP      3328
#define XB_TOPGEN   3392
#define XCD_BAR_WORDS 3456
#define XB_SPIN_CAP (1u << 20)
__device__ __forceinline__ unsigned xb_ld(unsigned* p)              { return __hip_atomic_load(p, __ATOMIC_RELAXED, __HIP_MEMORY_SCOPE_AGENT); }
__device__ __forceinline__ unsigned xb_add(unsigned* p, unsigned v) { return __hip_atomic_fetch_add(p, v, __ATOMIC_RELAXED, __HIP_MEMORY_SCOPE_AGENT); }
__device__ __forceinline__ unsigned xb_xcc_id() { return (unsigned)__builtin_amdgcn_s_getreg((3 << 11) | 20) & 0xFu; }
#define XB_SPIN(cond, bar) do { unsigned _sp = 0; while (cond) { __builtin_amdgcn_s_sleep(1); \
    if ((++_sp & 255u) == 0u) { if (xb_ld(&(bar)[XB_TMO])) break; if (_sp > XB_SPIN_CAP) { atomicAdd(&(bar)[XB_TMO], 1u); break; } } } } while (0)
struct XcdBarrier { unsigned* bar; unsigned x; volatile LAS unsigned* st; };
__device__ __forceinline__ XcdBarrier xcd_barrier_post(unsigned* bar, volatile LAS unsigned* st) {
    XcdBarrier b; b.bar = bar; b.x = xb_xcc_id(); b.st = st;
    if (threadIdx.x == 0) (void)xb_add(&bar[XB_XCNT(b.x)], 1u);
    return b;
}
__device__ __forceinline__ void xcd_barrier_complete(unsigned* bar, unsigned x, unsigned& nloc, unsigned& nx) {
    const unsigned G = gridDim.x * gridDim.y * gridDim.z;
    unsigned sum, cnt, mine, sp = 0u;
    for (;;) {
        sum = 0u; cnt = 0u; mine = 0u;
#pragma unroll
        for (unsigned j = 0; j < 16; ++j) { const unsigned c = xb_ld(&bar[XB_XCNT(j)]); sum += c; cnt += (c > 0u) ? 1u : 0u; mine = (j == x) ? c : mine; }
        if (sum == G) break;
        __builtin_amdgcn_s_sleep(1);
        if ((++sp & 255u) == 0u) { if (xb_ld(&bar[XB_TMO])) break; if (sp > XB_SPIN_CAP) { atomicAdd(&bar[XB_TMO], 1u); break; } }
    }
    nloc = mine > 0u ? mine : 1u; nx = cnt > 0u ? cnt : 1u;
}
__device__ __forceinline__ void xcd_barrier(const XcdBarrier& b) {
    asm volatile("s_waitcnt vmcnt(0)" ::: "memory");
    __syncthreads();
    if (threadIdx.x == 0) {
        unsigned* bar = b.bar;
        __builtin_amdgcn_s_waitcnt(0);
        unsigned nloc = b.st[0], nx = b.st[1];
        if (nloc == 0u) { xcd_barrier_complete(bar, b.x, nloc, nx); b.st[0] = nloc; b.st[1] = nx; }
        const unsigned old = xb_add(&bar[XB_XSUB(b.x)], 1u);
        const unsigned gen = old / nloc;
        if (old + 1u == (gen + 1u) * nloc) {
            __builtin_amdgcn_fence(__ATOMIC_RELEASE, "agent");
            asm volatile("s_waitcnt vmcnt(0)" ::: "memory");
            const unsigned og = xb_add(&bar[XB_TOP], 1u);
            const unsigned tg = og / nx;
            if (og + 1u == (tg + 1u) * nx) xb_add(&bar[XB_TOPGEN], 1u);
            else XB_SPIN(xb_ld(&bar[XB_TOPGEN]) == tg, bar);
            __builtin_amdgcn_fence(__ATOMIC_ACQUIRE, "agent");
            xb_add(&bar[XB_XGEN(b.x)], 1u);
            asm volatile("s_waitcnt vmcnt(0)" ::: "memory");
        } else {
            XB_SPIN(xb_ld(&bar[XB_XGEN(b.x)]) == gen, bar);
            __builtin_amdgcn_fence(__ATOMIC_ACQUIRE, "agent");
            asm volatile("s_waitcnt vmcnt(0)" ::: "memory");
        }
    }
    __syncthreads();
}

namespace pg8 {
constexpr int BM = 256, BK = 64, HALF = 128, HTB = HALF * BK * 2, STAGE_BYTES = 8 * HTB, NXCD = 8, WGM = 6;
__host__ __device__ __forceinline__ int lds_byte(int r, int c) { const int st = (r >> 4) * 2 + (c >> 5), rr = r & 15, cc = c & 31, ob = rr * 64 + cc * 2; return st * 1024 + (ob ^ (((ob >> 9) & 1) << 5)); }
__host__ __device__ __forceinline__ void stage_rc(int b, int& R, int& C) { const int st = b / 1024, sb = b % 1024, swz = sb ^ (((sb >> 9) & 1) << 5); R = (st >> 1) * 16 + swz / 64; C = (st & 1) * 32 + (swz % 64) / 2; }
__host__ __device__ __forceinline__ int perm32(int rho) { const int n = rho >> 4, i = rho & 15; return 8 * (i >> 2) + 4 * n + (i & 3); }

struct Unit { const char* A; const char* B; int pm, pn, z, pad; };
__device__ __forceinline__ void tile_order(int L, int nM, int nN, int& pm, int& pn) {
    const int nwg = nM * nN; int wgid = L;
    { const int q = nwg / NXCD, r = nwg % NXCD, xcd = wgid % NXCD, off = wgid / NXCD; wgid = (xcd < r ? xcd * (q + 1) : r * (q + 1) + (xcd - r) * q) + off; }
    const int nig = WGM * nN, gid = wgid / nig, fm = gid * WGM, gsz = (nM - fm) < WGM ? (nM - fm) : WGM;
    pm = fm + ((wgid % nig) % gsz); pn = (wgid % nig) / gsz;
}
struct SchedGrid {
    const char* A; const char* B; int lda, ldb, nM, nN, G, c;
    __device__ __forceinline__ bool next(int i, Unit& u) const {
        const long L = (long)i * G + c; if (L >= (long)nM * nN) return false;
        tile_order((int)L, nM, nN, u.pm, u.pn); u.z = 0; u.pad = 0;
        u.A = A + (size_t)u.pm * 256 * lda * 2; u.B = B + (size_t)u.pn * 256 * ldb * 2; return true;
    }
};

typedef f32x4 Acc[2][2][4][2];

template <class Epi, class Sched, bool ALIGN_EPI, bool SP2, bool I8 = false, bool APERM = false>
__device__ __forceinline__ void gemm_phase(LAS unsigned char* lds, const int K, const int lda, const int ldb, const Sched& S, const Epi& E) {
    const int tid = threadIdx.x, wid = __builtin_amdgcn_readfirstlane(tid >> 6), lane = tid & 63, wr = wid >> 2, wc = wid & 3, fr = lane & 15, fq = lane >> 4;
    int Ko = K; asm volatile("" : "+s"(Ko));
    const int nt = Ko / BK;
    unsigned voffA[2], voffB[2];
#pragma unroll
    for (int i = 0; i < 2; ++i) { int R, C; stage_rc(tid * 16 + i * 8192, R, C); const int Rb = (R & ~31) + perm32(R & 31);
        const int Ra = APERM ? ((R & ~63) + 4 * (R & 15) + ((R >> 4) & 3)) : R;
        voffA[i] = (unsigned)(Ra * lda + C) * 2u; voffB[i] = (unsigned)(Rb * ldb + C) * 2u; }
    const size_t kstep = (size_t)(BK * 2);
    const size_t hstepA = (size_t)HALF * lda * 2, hstepB = (size_t)HALF * ldb * 2;
    const unsigned ldsw = (unsigned)wid * 1024u;
    const int aoff = lds_byte(wr * 64 + fr, fq * 8), boff = lds_byte(wc * 32 + fr, fq * 8);
#define PG8_SA(b, h) (((b) * 2 + (h)) * HTB)
#define PG8_SB(b, h) ((4 + (b) * 2 + (h)) * HTB)
#define PG8_STAGE(bufoff, gbase, voff) do { _Pragma("unroll") for (int _i = 0; _i < 2; ++_i) \
        __builtin_amdgcn_global_load_lds((const unsigned*)((const char*)(gbase) + (voff)[_i]), (LAS unsigned*)(lds + (bufoff) + ldsw + _i * 8192), 16, 0, 0); } while (0)
#define PG8_LDA(dst, b, h) do { _Pragma("unroll") for (int m = 0; m < 4; ++m) _Pragma("unroll") for (int k = 0; k < 2; ++k) dst[m][k] = *(const LAS bf16x8*)(lds + PG8_SA(b, h) + aoff + m * 2048 + k * 1024); } while (0)
#define PG8_LDB(dst, b, h) do { _Pragma("unroll") for (int n = 0; n < 2; ++n) _Pragma("unroll") for (int k = 0; k < 2; ++k) dst[n][k] = *(const LAS bf16x8*)(lds + PG8_SB(b, h) + boff + n * 2048 + k * 1024); } while (0)
#define PG8_MMA(ai, bj, At, Bt) do { __builtin_amdgcn_s_setprio(1); _Pragma("unroll") for (int m = 0; m < 4; ++m) _Pragma("unroll") for (int n = 0; n < 2; ++n) _Pragma("unroll") for (int k = 0; k < 2; ++k) { \
        if constexpr (I8) acc[ai][bj][m][n] = __builtin_bit_cast(f32x4, __builtin_amdgcn_mfma_i32_16x16x64_i8(__builtin_bit_cast(i32x4, Bt[n][k]), __builtin_bit_cast(i32x4, At[m][k]), __builtin_bit_cast(i32x4, acc[ai][bj][m][n]), 0, 0, 0)); \
        else acc[ai][bj][m][n] = __builtin_amdgcn_mfma_f32_16x16x32_bf16(Bt[n][k], At[m][k], acc[ai][bj][m][n], 0, 0, 0); } __builtin_amdgcn_s_setprio(0); } while (0)
#define PG8_WAIT_V(n) asm volatile("s_waitcnt vmcnt(" #n ")" ::: "memory")
#define PG8_WAIT_L(n) asm volatile("s_waitcnt lgkmcnt(" #n ")" ::: "memory")
#define PG8_BAR __builtin_amdgcn_s_barrier()
#define PG8_SCHED __builtin_amdgcn_sched_barrier(0)
    Unit cur, nxt; int ui = 0;
    if (!S.next(0, cur)) return;
    Acc acc;
#pragma unroll
    for (int a = 0; a < 2; ++a)
#pragma unroll
        for (int b = 0; b < 2; ++b)
#pragma unroll
            for (int m = 0; m < 4; ++m)
#pragma unroll
                for (int n = 0; n < 2; ++n) acc[a][b][m][n] = (f32x4){0.f, 0.f, 0.f, 0.f};
    bf16x8 At[4][2], B0[2][2], B1[2][2];
    const char* cA = cur.A; const char* cB = cur.B;
    if constexpr (SP2) {
        PG8_STAGE(PG8_SB(0, 0), cB, voffB); PG8_STAGE(PG8_SB(0, 1), cB + hstepB, voffB); PG8_STAGE(PG8_SA(0, 0), cA, voffA); PG8_STAGE(PG8_SA(0, 1), cA + hstepA, voffA);
        if (wr == 1) PG8_BAR;
        PG8_WAIT_V(2); PG8_BAR;
        PG8_STAGE(PG8_SB(1, 0), cB + kstep, voffB); PG8_STAGE(PG8_SA(1, 0), cA + kstep, voffA); PG8_STAGE(PG8_SB(1, 1), cB + hstepB + kstep, voffB);
        PG8_WAIT_V(6); PG8_BAR;
    } else {
        PG8_STAGE(PG8_SB(0, 0), cB, voffB); PG8_STAGE(PG8_SA(0, 0), cA, voffA); PG8_STAGE(PG8_SB(0, 1), cB + hstepB, voffB); PG8_STAGE(PG8_SA(0, 1), cA + hstepA, voffA);
        if (wr == 1) PG8_BAR;
        PG8_WAIT_V(4); PG8_BAR;
        PG8_STAGE(PG8_SB(1, 0), cB + kstep, voffB); PG8_STAGE(PG8_SA(1, 0), cA + kstep, voffA); PG8_STAGE(PG8_SB(1, 1), cB + hstepB + kstep, voffB);
        PG8_WAIT_V(6); PG8_BAR;
    }
    for (;;) {
        const bool has_next = S.next(ui + 1, nxt);
        const char* nA = has_next ? nxt.A : cA; const char* nB = has_next ? nxt.B : cB;
        for (int t = 0; t < nt; t += 2) {
            const bool last = (t == nt - 2);
            const char* a1 = cA + (size_t)(t + 1) * kstep;
            const char* a2 = last ? nA : cA + (size_t)(t + 2) * kstep; const char* b2 = last ? nB : cB + (size_t)(t + 2) * kstep;
            const char* a3 = a2 + kstep; const char* b3 = b2 + kstep;
            if constexpr (SP2) {
            PG8_LDB(B0, 0, 0); PG8_LDB(B1, 0, 1); PG8_SCHED; PG8_LDA(At, 0, 0); PG8_STAGE(PG8_SA(1, 1), a1 + hstepA, voffA);
            PG8_WAIT_V(8); PG8_WAIT_L(0); PG8_BAR; PG8_MMA(0, 0, At, B0); PG8_MMA(0, 1, At, B1); PG8_BAR; PG8_SCHED;
            PG8_LDA(At, 0, 1); PG8_STAGE(PG8_SB(0, 0), b2, voffB); PG8_STAGE(PG8_SB(0, 1), b2 + hstepB, voffB); PG8_STAGE(PG8_SA(0, 0), a2, voffA);
            PG8_WAIT_V(8); PG8_WAIT_L(0); PG8_BAR; PG8_MMA(1, 0, At, B0); PG8_MMA(1, 1, At, B1); PG8_BAR; PG8_SCHED;
            PG8_LDB(B0, 1, 0); PG8_LDB(B1, 1, 1); PG8_SCHED; PG8_LDA(At, 1, 0); PG8_STAGE(PG8_SA(0, 1), a2 + hstepA, voffA);
            PG8_WAIT_V(8); PG8_WAIT_L(0); PG8_BAR; PG8_MMA(0, 0, At, B0); PG8_MMA(0, 1, At, B1); PG8_BAR; PG8_SCHED;
            PG8_LDA(At, 1, 1); PG8_STAGE(PG8_SB(1, 0), b3, voffB); PG8_STAGE(PG8_SB(1, 1), b3 + hstepB, voffB); PG8_STAGE(PG8_SA(1, 0), a3, voffA);
            PG8_WAIT_V(8); PG8_WAIT_L(0); PG8_BAR; PG8_MMA(1, 0, At, B0); PG8_MMA(1, 1, At, B1); PG8_BAR; PG8_SCHED;
            } else {
            PG8_LDB(B0, 0, 0); PG8_SCHED; PG8_LDA(At, 0, 0); PG8_STAGE(PG8_SA(1, 1), a1 + hstepA, voffA);
            PG8_WAIT_L(8); PG8_BAR; PG8_WAIT_L(0); PG8_MMA(0, 0, At, B0); PG8_BAR; PG8_SCHED;
            PG8_LDB(B1, 0, 1); PG8_STAGE(PG8_SB(0, 0), b2, voffB);
            PG8_BAR; PG8_WAIT_L(0); PG8_MMA(0, 1, At, B1); PG8_BAR;
            PG8_LDA(At, 0, 1); PG8_STAGE(PG8_SA(0, 0), a2, voffA);
            PG8_BAR; PG8_WAIT_L(0); PG8_MMA(1, 0, At, B0); PG8_BAR; PG8_SCHED;
            PG8_STAGE(PG8_SB(0, 1), b2 + hstepB, voffB);
            PG8_WAIT_V(6); PG8_BAR; PG8_MMA(1, 1, At, B1); PG8_BAR;
            PG8_LDB(B0, 1, 0); PG8_SCHED; PG8_LDA(At, 1, 0); PG8_STAGE(PG8_SA(0, 1), a2 + hstepA, voffA);
            PG8_WAIT_L(8); PG8_BAR; PG8_WAIT_L(0); PG8_MMA(0, 0, At, B0); PG8_BAR; PG8_SCHED;
            PG8_LDB(B1, 1, 1); PG8_STAGE(PG8_SB(1, 0), b3, voffB);
            PG8_BAR; PG8_WAIT_L(0); PG8_MMA(0, 1, At, B1); PG8_BAR;
            PG8_LDA(At, 1, 1); PG8_STAGE(PG8_SA(1, 0), a3, voffA);
            PG8_BAR; PG8_WAIT_L(0); PG8_MMA(1, 0, At, B0); PG8_BAR; PG8_SCHED;
            PG8_STAGE(PG8_SB(1, 1), b3 + hstepB, voffB);
            PG8_WAIT_V(6); PG8_BAR; PG8_MMA(1, 1, At, B1); PG8_BAR;
            }
        }
        if constexpr (ALIGN_EPI) { if (wr == 0) PG8_BAR; }
        E(acc, cur, wr, wc, fr, fq);
        if (!has_next) break;
#pragma unroll
        for (int a = 0; a < 2; ++a)
#pragma unroll
            for (int b = 0; b < 2; ++b)
#pragma unroll
                for (int m = 0; m < 4; ++m)
#pragma unroll
                    for (int n = 0; n < 2; ++n) acc[a][b][m][n] = (f32x4){0.f, 0.f, 0.f, 0.f};
        cur = nxt; cA = nA; cB = nB; ++ui;
        if constexpr (ALIGN_EPI) { if (wr == 1) PG8_BAR; }
    }
    PG8_WAIT_V(0);
    if constexpr (!ALIGN_EPI) { if (wr == 0) PG8_BAR; }
    PG8_BAR;
#undef PG8_SA
#undef PG8_SB
#undef PG8_STAGE
#undef PG8_LDA
#undef PG8_LDB
#undef PG8_MMA
#undef PG8_WAIT_V
#undef PG8_WAIT_L
#undef PG8_BAR
#undef PG8_SCHED
}

#define EPI_ROWS_BEGIN _Pragma("unroll") for (int ai = 0; ai < 2; ++ai) _Pragma("unroll") for (int m = 0; m < 4; ++m) {
#define EPI_ROWS_END }
template <int MODE> struct EpiBf16 {
    bf16_t* O; int ldc; const float* bias0; const float* bias1;
    const float* rs0; const float* wmin;
    float* lnst;
    bf16_t* OH; bf16_t* OL;
    __device__ __forceinline__ void operator()(const Acc& acc, const Unit& u, int wr, int wc, int fr, int fq) const {
        const int row0 = u.pm * BM + wr * 64 + fr, col0 = u.pn * BM + wc * 32 + 8 * fq;
        const bool gel = (MODE == 1) && (u.pn < 16);
        f32x4 bv[2][2]; float sc = 1.f;
        if (MODE == 2) { const int bq = u.pn >> 3; const float* bp = (bq < 2 ? bias0 + bq * 2048 : bias1 + (bq - 2) * 2048) + (col0 & 2047); sc = bq < 2 ? 0.6065306597126334f : 1.f;
#pragma unroll
            for (int bj = 0; bj < 2; ++bj)
#pragma unroll
                for (int n = 0; n < 2; ++n) bv[bj][n] = *(const f32x4*)(bp + bj * HALF + 4 * n) * -1.4426950408889634f; }
        EPI_ROWS_BEGIN
            const int row = row0 + ai * HALF + m * 16; float ls1 = 0.f, ls2 = 0.f;
            bf16_t* rowp = O + (size_t)row * ldc + col0;
            if (MODE == 1) { if (u.pn >= 40) rowp = OL + (size_t)row * 768 + (col0 - 10240); }
#pragma unroll
            for (int bj = 0; bj < 2; ++bj) { f32x4 v0 = acc[ai][bj][m][0], v1 = acc[ai][bj][m][1];
                if (MODE == 1) { if (u.pn >= I8_LO && u.pn < I8_HI) { const i32x4 i0 = __builtin_bit_cast(i32x4, v0), i1 = __builtin_bit_cast(i32x4, v1); const float rq = rs0[row] * (1.0f / 127.0f);
                    const float* wp = wmin + (col0 + bj * HALF - 4096);
                    v0 = (f32x4){(float)i0[0], (float)i0[1], (float)i0[2], (float)i0[3]} * (*(const f32x4*)wp * rq); v1 = (f32x4){(float)i1[0], (float)i1[1], (float)i1[2], (float)i1[3]} * (*(const f32x4*)(wp + 4) * rq); } }
                bf16_t* dst = rowp + bj * HALF;
                if (MODE == 1) { if (u.pn >= 16 && u.pn < 40) { const int c = col0 + bj * HALF - 4096; dst = OH + ((size_t)(c >> 6) * MTOK + row) * 64 + (c & 63); } }
                if (MODE == 2) { const int c = col0 + bj * HALF; dst = O + ((size_t)(c >> 6) * MTOK + row) * 64 + (c & 63); }
                if (MODE == 1) { if (gel) { v0 = gelu_tanh4(v0); v1 = gelu_tanh4(v1); } }
                if (MODE == 2) { v0 = sigmoid_bias4(v0, bv[bj][0], sc); v1 = sigmoid_bias4(v1, bv[bj][1], sc); }
                u32x4 w; w.x = cvt_pk_bf16(v0[0], v0[1]); w.y = cvt_pk_bf16(v0[2], v0[3]); w.z = cvt_pk_bf16(v1[0], v1[1]); w.w = cvt_pk_bf16(v1[2], v1[3]);
                *(u32x4*)dst = w;
                if (MODE == 1) { if (u.pn >= 8 && u.pn < 16) {
                    const float a0 = bflo(w.x), a1 = bfhi(w.x), a2 = bflo(w.y), a3 = bfhi(w.y), a4 = bflo(w.z), a5 = bfhi(w.z), a6 = bflo(w.w), a7 = bfhi(w.w);
                    ls1 += ((a0 + a1) + (a2 + a3)) + ((a4 + a5) + (a6 + a7)); ls2 += ((a0 * a0 + a1 * a1) + (a2 * a2 + a3 * a3)) + ((a4 * a4 + a5 * a5) + (a6 * a6 + a7 * a7)); } } }
            if (MODE == 1) { if (u.pn >= 8 && u.pn < 16) { ls1 += __shfl_xor(ls1, 16); ls1 += __shfl_xor(ls1, 32); ls2 += __shfl_xor(ls2, 16); ls2 += __shfl_xor(ls2, 32);
                if (fq == 0) { atomicAdd(lnst + 2 * row, ls1); atomicAdd(lnst + 2 * row + 1, ls2); } } }
        EPI_ROWS_END
    }
};
struct EpiRes {
    const float* resf; const float* resf1; bf16_t* xb; float* ss;
    __device__ __forceinline__ void operator()(const Acc& acc, const Unit& u, int wr, int wc, int fr, int fq) const {
        const int row0 = u.pm * BM + wr * 64 + fr, col0 = u.pn * BM + wc * 32 + 8 * fq;
        EPI_ROWS_BEGIN
            const int row = row0 + ai * HALF + m * 16;
            bf16_t* xp = xb + (size_t)row * DM + col0; float q = 0.f;
#pragma unroll
            for (int bj = 0; bj < 2; ++bj) {
                f32x4 r0, r1;
                if (resf) { const float* rp = (row < NTP ? resf + (size_t)row * DM : resf1 + (size_t)(row - NTP) * DM) + col0 + bj * HALF; r0 = *(const f32x4*)rp; r1 = *(const f32x4*)(rp + 4); }
                else { float f[8]; unpack8(*(const u32x4*)(xp + bj * HALF), f); r0 = (f32x4){f[0], f[1], f[2], f[3]}; r1 = (f32x4){f[4], f[5], f[6], f[7]}; }
                const f32x4 v0 = acc[ai][bj][m][0] + r0, v1 = acc[ai][bj][m][1] + r1;
                q += (v0[0] * v0[0] + v0[1] * v0[1]) + (v0[2] * v0[2] + v0[3] * v0[3]) + (v1[0] * v1[0] + v1[1] * v1[1]) + (v1[2] * v1[2] + v1[3] * v1[3]);
                u32x4 w; w.x = cvt_pk_bf16(v0[0], v0[1]); w.y = cvt_pk_bf16(v0[2], v0[3]); w.z = cvt_pk_bf16(v1[0], v1[1]); w.w = cvt_pk_bf16(v1[2], v1[3]);
                *(u32x4*)(xp + bj * HALF) = w; }
            q += __shfl_xor(q, 16); q += __shfl_xor(q, 32);
            if (fq == 0) atomicAdd(ss + row, q);
        EPI_ROWS_END
    }
};
struct EpiQKV {
    bf16_t* Q; bf16_t* KB; bf16_t* VT; const float* ss;
    __device__ __forceinline__ void operator()(const Acc& acc, const Unit& u, int wr, int wc, int fr, int fq) const {
        const int row0 = u.pm * BM + wr * 64 + fr, col0 = u.pn * BM + wc * 32 + 8 * fq;
        bf16_t* O = u.z == 0 ? Q : (u.z == 1 ? KB : VT); const int ldc = u.z == 2 ? 2048 : DM;
        EPI_ROWS_BEGIN
            const int row = row0 + ai * HALF + m * 16;
            float rs = 1.f; if (u.z == 0) rs = __builtin_amdgcn_rsqf(ss[row] * (1.0f / DM) + RMS_EPS);
            bf16_t* rowp = O + (size_t)row * ldc + col0;
#pragma unroll
            for (int bj = 0; bj < 2; ++bj) { const f32x4 v0 = acc[ai][bj][m][0] * rs, v1 = acc[ai][bj][m][1] * rs;
                u32x4 w; w.x = cvt_pk_bf16(v0[0], v0[1]); w.y = cvt_pk_bf16(v0[2], v0[3]); w.z = cvt_pk_bf16(v1[0], v1[1]); w.w = cvt_pk_bf16(v1[2], v1[3]);
                *(u32x4*)(rowp + bj * HALF) = w; }
        EPI_ROWS_END
    }
};
struct EpiSoftmax {
    bf16_t* P; LAS float* xs; const float* ss;
    __device__ __forceinline__ void operator()(const Acc& acc, const Unit& u, int wr, int wc, int fr, int fq) const {
        const float scale = 0.03125f * 1.4426950408889634f;
        const int srow0 = u.pm * BM + wr * 64 + fr;
        float mx[2][4], sc[2][4];
        EPI_ROWS_BEGIN
            sc[ai][m] = scale * __builtin_amdgcn_rsqf(ss[srow0 + ai * HALF + m * 16] * (1.0f / DM) + RMS_EPS);
            float x = -3.0e38f;
#pragma unroll
            for (int bj = 0; bj < 2; ++bj)
#pragma unroll
                for (int n = 0; n < 2; ++n)
#pragma unroll
                    for (int j = 0; j < 4; ++j) x = fmaxf(x, acc[ai][bj][m][n][j]);
            x = fmaxf(x, __shfl_xor(x, 16)); x = fmaxf(x, __shfl_xor(x, 32));
            if (fq == 0) xs[(ai * HALF + wr * 64 + m * 16 + fr) * 4 + wc] = x;
        EPI_ROWS_END
        LDS_WAIT(); __builtin_amdgcn_s_barrier(); asm volatile("" ::: "memory");
        float sm[2][4];
        EPI_ROWS_BEGIN
            const f32x4 t = *(const LAS f32x4*)(xs + (ai * HALF + wr * 64 + m * 16 + fr) * 4);
            mx[ai][m] = fmaxf(fmaxf(t[0], t[1]), fmaxf(t[2], t[3])) * sc[ai][m];
            float s = 0.f;
#pragma unroll
            for (int bj = 0; bj < 2; ++bj)
#pragma unroll
                for (int n = 0; n < 2; ++n)
#pragma unroll
                    for (int j = 0; j < 4; ++j) s += __builtin_amdgcn_exp2f(acc[ai][bj][m][n][j] * sc[ai][m] - mx[ai][m]);
            s += __shfl_xor(s, 16); s += __shfl_xor(s, 32);
            if (fq == 0) xs[1024 + (ai * HALF + wr * 64 + m * 16 + fr) * 4 + wc] = s;
        EPI_ROWS_END
        LDS_WAIT(); __builtin_amdgcn_s_barrier(); asm volatile("" ::: "memory");
        const int row0 = u.pm * BM + wr * 64 + fr, col0 = u.pn * BM + wc * 32 + 8 * fq;
        EPI_ROWS_BEGIN
            const f32x4 t = *(const LAS f32x4*)(xs + 1024 + (ai * HALF + wr * 64 + m * 16 + fr) * 4);
            sm[ai][m] = frcp((t[0] + t[1]) + (t[2] + t[3]));
            bf16_t* rowp = P + (size_t)(row0 + ai * HALF + m * 16) * 1024 + col0;
#pragma unroll
            for (int bj = 0; bj < 2; ++bj) { f32x4 v0, v1;
#pragma unroll
                for (int j = 0; j < 4; ++j) { v0[j] = __builtin_amdgcn_exp2f(acc[ai][bj][m][0][j] * sc[ai][m] - mx[ai][m]) * sm[ai][m]; v1[j] = __builtin_amdgcn_exp2f(acc[ai][bj][m][1][j] * sc[ai][m] - mx[ai][m]) * sm[ai][m]; }
                u32x4 w; w.x = cvt_pk_bf16(v0[0], v0[1]); w.y = cvt_pk_bf16(v0[2], v0[3]); w.z = cvt_pk_bf16(v1[0], v1[1]); w.w = cvt_pk_bf16(v1[2], v1[3]);
                *(u32x4*)(rowp + bj * HALF) = w; }
        EPI_ROWS_END
    }
};
struct EpiGate {
    bf16_t* CAT; const bf16_t* YF; const bf16_t* ZV; const float* SB; const float* gng; const float* gnb; const float* muv; LAS float* xs2;
    __device__ __forceinline__ void operator()(const Acc& acc, const Unit& u, int wr, int wc, int fr, int fq) const {
        const int rl0 = wr * 64 + fr, row0 = u.pm * BM + rl0;
        EPI_ROWS_BEGIN
            int rl = rl0 + ai * HALF + m * 16; asm volatile("" : "+v"(rl));
            const int row = u.pm * BM + rl;
#pragma unroll
            for (int bj = 0; bj < 2; ++bj) { const int c8 = u.pn * BM + bj * HALF + wc * 32 + 8 * fq;
                float a[8], b[8]; unpack8(*(const u32x4*)(YF + (size_t)row * 2048 + c8), a); unpack8(*(const u32x4*)(YF + (size_t)(MTOK + row) * 2048 + c8), b);
                float s = 0.f, q = 0.f;
#pragma unroll
                for (int j = 0; j < 8; ++j) { const float y = a[j] + b[j]; s += y; q += y * y; }
                s += __shfl_xor(s, 16); s += __shfl_xor(s, 32); q += __shfl_xor(q, 16); q += __shfl_xor(q, 32);
                if (fq == 0) *(LAS f32x2*)(xs2 + (((rl * 4 + 2 * bj + (wc >> 1)) * 2 + (wc & 1)) * 2)) = (f32x2){s, q}; }
            asm volatile("" ::: "memory");
        EPI_ROWS_END
        LDS_WAIT(); __builtin_amdgcn_s_barrier(); asm volatile("" ::: "memory");
#pragma unroll
        for (int bj = 0; bj < 2; ++bj) {
            const int c8 = u.pn * BM + bj * HALF + wc * 32 + 8 * fq, hh = c8 >> 6;
            const f32x4 gg0 = *(const f32x4*)(gng + c8), gg1 = *(const f32x4*)(gng + c8 + 4), gb0 = *(const f32x4*)(gnb + c8), gb1 = *(const f32x4*)(gnb + c8 + 4), mv0 = *(const f32x4*)(muv + c8), mv1 = *(const f32x4*)(muv + c8 + 4);
#pragma unroll
            for (int ai = 0; ai < 2; ++ai)
#pragma unroll
                for (int m = 0; m < 4; ++m) {
                    int rl = rl0 + ai * HALF + m * 16; asm volatile("" : "+v"(rl));
                    const int row = u.pm * BM + rl;
                    const int sst = seq_start_of_row(row), T = seq_len_of_row(row), t = row - sst;
                    float a[8], b[8]; unpack8(*(const u32x4*)(YF + (size_t)row * 2048 + c8), a); unpack8(*(const u32x4*)(YF + (size_t)(MTOK + row) * 2048 + c8), b);
                    const f32x4 st = *(const LAS f32x4*)(xs2 + (rl * 4 + 2 * bj + (wc >> 1)) * 4);
                    const float mean = (st[0] + st[2]) * (1.f / 64.f), var = fmaxf((st[1] + st[3]) * (1.f / 64.f) - mean * mean, 0.f), rstd = __builtin_amdgcn_rsqf(var + GN_EPS);
                    const bf16_t* zp = ZV + ((size_t)hh * MTOK + row) * 64 + (c8 & 63);
                    float vc[8], vp[8], vn[8]; unpack8(*(const u32x4*)zp, vc);
                    { u32x4 wp = *(const u32x4*)(zp - (t > 0 ? 64 : 0)), wn = *(const u32x4*)(zp + (t < T - 1 ? 64 : 0));
                      if (!(t > 0)) wp = (u32x4){0u, 0u, 0u, 0u}; if (!(t < T - 1)) wn = (u32x4){0u, 0u, 0u, 0u};
                      unpack8(wp, vp); unpack8(wn, vn); }
                    const float bon = SB[(size_t)row * NH + hh] + SB[(size_t)(MTOK + row) * NH + hh];
                    float o[8];
#pragma unroll
                    for (int j = 0; j < 8; ++j) { const float gg = j < 4 ? gg0[j & 3] : gg1[j & 3], gb = j < 4 ? gb0[j & 3] : gb1[j & 3], mv = j < 4 ? mv0[j & 3] : mv1[j & 3];
                        const float g = j < 4 ? acc[ai][bj][m][0][j & 3] : acc[ai][bj][m][1][j & 3];
                        const float v_ = vc[j] + mv * (0.5f * (vp[j] + vn[j]) - vc[j]);
                        o[j] = (((a[j] + b[j]) - mean) * rstd * gg + gb + bon * v_) * g; }
                    *(u32x4*)(CAT + (size_t)row * DM + 2048 + c8) = pack8(o);
                    asm volatile("" ::: "memory");
                }
        }
        (void)row0;
    }
};
__device__ __forceinline__ float dpp_ror1(float x) { return __builtin_bit_cast(float, __builtin_amdgcn_update_dpp(0, __builtin_bit_cast(int, x), 0x121, 0xF, 0xF, true)); }
__device__ __forceinline__ float dpp_ror15(float x) { return __builtin_bit_cast(float, __builtin_amdgcn_update_dpp(0, __builtin_bit_cast(int, x), 0x12F, 0xF, 0xF, true)); }
__device__ __forceinline__ float dpp_shr1_old(float old, float x) { return __builtin_bit_cast(float, __builtin_amdgcn_update_dpp(__builtin_bit_cast(int, old), __builtin_bit_cast(int, x), 0x111, 0xF, 0xF, false)); }
__device__ __forceinline__ float dpp_shl1_old(float old, float x) { return __builtin_bit_cast(float, __builtin_amdgcn_update_dpp(__builtin_bit_cast(int, old), __builtin_bit_cast(int, x), 0x101, 0xF, 0xF, false)); }
struct EpiUp {
    bf16_t* Aout; float* ZB; const float* zs; const float* wmax; const float* cw; const float* cb; LAS float* xs;
    __device__ __forceinline__ void operator()(Acc& acc, const Unit& u, int wr, int wc, int fr, int fq) const {
        const int rowb = u.pm * BM + wr * 64 + 4 * fr;
        const int hc0 = u.pn * HALF + wc * 32 + 8 * fq;
#pragma unroll
        for (int ai = 0; ai < 2; ++ai) { const f32x4 rs4 = *(const f32x4*)(zs + rowb + ai * HALF) * (1.0f / 127.0f);
#pragma unroll
            for (int m = 0; m < 4; ++m)
#pragma unroll
                for (int bj = 0; bj < 2; ++bj)
#pragma unroll
                    for (int n = 0; n < 2; ++n) { const i32x4 ia = __builtin_bit_cast(i32x4, acc[ai][bj][m][n]); acc[ai][bj][m][n] = (f32x4){(float)ia[0], (float)ia[1], (float)ia[2], (float)ia[3]} * rs4[m]; } }
        const int lcol = wc * 32 + 8 * fq;
#pragma unroll
        for (int ai = 0; ai < 2; ++ai) {
            if (fr == 0) {
#pragma unroll
                for (int bj = 0; bj < 2; ++bj)
#pragma unroll
                    for (int n = 0; n < 2; ++n) *(LAS f32x4*)(xs + ((ai * 2 + wr) * 2 + 0) * 256 + bj * HALF + lcol + 4 * n) = acc[ai][bj][0][n]; }
            if (fr == 15) {
#pragma unroll
                for (int bj = 0; bj < 2; ++bj)
#pragma unroll
                    for (int n = 0; n < 2; ++n) *(LAS f32x4*)(xs + ((ai * 2 + wr) * 2 + 1) * 256 + bj * HALF + lcol + 4 * n) = acc[ai][bj][3][n]; }
        }
        if (wr == 0 && fr == 0) {
#pragma unroll
            for (int bj = 0; bj < 2; ++bj)
#pragma unroll
                for (int n = 0; n < 2; ++n) { const f32x4 ws = *(const f32x4*)(wmax + bj * DFF + hc0 + 4 * n);
                    *(f32x4*)(ZB + ((size_t)u.pm * 4 + 0) * NUP + bj * DFF + hc0 + 4 * n) = acc[0][bj][0][n] * ws; *(f32x4*)(ZB + ((size_t)u.pm * 4 + 1) * NUP + bj * DFF + hc0 + 4 * n) = acc[0][bj][1][n] * ws; } }
        if (wr == 1 && fr == 15) {
#pragma unroll
            for (int bj = 0; bj < 2; ++bj)
#pragma unroll
                for (int n = 0; n < 2; ++n) { const f32x4 ws = *(const f32x4*)(wmax + bj * DFF + hc0 + 4 * n);
                    *(f32x4*)(ZB + ((size_t)u.pm * 4 + 2) * NUP + bj * DFF + hc0 + 4 * n) = acc[1][bj][2][n] * ws; *(f32x4*)(ZB + ((size_t)u.pm * 4 + 3) * NUP + bj * DFF + hc0 + 4 * n) = acc[1][bj][3][n] * ws; } }
        LDS_WAIT(); __builtin_amdgcn_s_barrier(); asm volatile("" ::: "memory");
#pragma unroll
        for (int n = 0; n < 2; ++n) {
            f32x4 c0[2], c1[2], c2[2], cbv[2];
#pragma unroll
            for (int bj = 0; bj < 2; ++bj) { const int c = bj * DFF + hc0 + 4 * n; const float kc = bj == 0 ? -1.4426950408889634f : -0.6931471805599453f; const f32x4 cs = *(const f32x4*)(wmax + c) * kc;
                c0[bj] = *(const f32x4*)(cw + c) * cs; c1[bj] = *(const f32x4*)(cw + NUP + c) * cs; c2[bj] = *(const f32x4*)(cw + 2 * NUP + c) * cs; cbv[bj] = *(const f32x4*)(cb + c) * kc; }
#pragma unroll
            for (int ai = 0; ai < 2; ++ai) {
                f32x4 up[2], dn[2];
#pragma unroll
                for (int bj = 0; bj < 2; ++bj) {
                    const int blk = ai * 2 + wr;
                    up[bj] = blk > 0 ? *(const LAS f32x4*)(xs + (((blk - 1)) * 2 + 1) * 256 + bj * HALF + lcol + 4 * n) : (f32x4){0.f, 0.f, 0.f, 0.f};
                    dn[bj] = blk < 3 ? *(const LAS f32x4*)(xs + (((blk + 1)) * 2 + 0) * 256 + bj * HALF + lcol + 4 * n) : (f32x4){0.f, 0.f, 0.f, 0.f};
                }
                f32x4 cz[4][2];
#pragma unroll
                for (int bj = 0; bj < 2; ++bj) {
                    const f32x4 V0 = acc[ai][bj][0][n], V1 = acc[ai][bj][1][n], V2 = acc[ai][bj][2][n], V3 = acc[ai][bj][3][n];
                    f32x4 PV, NX;
#pragma unroll
                    for (int j = 0; j < 4; ++j) { PV[j] = dpp_shr1_old(up[bj][j], V3[j]); NX[j] = dpp_shl1_old(dn[bj][j], V0[j]); }
                    cz[0][bj] = __builtin_elementwise_fma(c2[bj], V1, __builtin_elementwise_fma(c1[bj], V0, __builtin_elementwise_fma(c0[bj], PV, cbv[bj])));
                    cz[1][bj] = __builtin_elementwise_fma(c2[bj], V2, __builtin_elementwise_fma(c1[bj], V1, __builtin_elementwise_fma(c0[bj], V0, cbv[bj])));
                    cz[2][bj] = __builtin_elementwise_fma(c2[bj], V3, __builtin_elementwise_fma(c1[bj], V2, __builtin_elementwise_fma(c0[bj], V1, cbv[bj])));
                    cz[3][bj] = __builtin_elementwise_fma(c2[bj], NX, __builtin_elementwise_fma(c1[bj], V3, __builtin_elementwise_fma(c0[bj], V2, cbv[bj])));
                }
#pragma unroll
                for (int m = 0; m < 4; ++m) {
                    f32x4 sg;
#pragma unroll
                    for (int j = 0; j < 4; ++j) sg[j] = frcp(1.0f + __builtin_amdgcn_exp2f(cz[m][0][j]));
                    const f32x4 o = (cz[m][0] * cz[m][1]) * sg;
                    u32x2 w; w.x = cvt_pk_bf16(o[0], o[1]); w.y = cvt_pk_bf16(o[2], o[3]);
                    *(u32x2*)(Aout + (size_t)(rowb + ai * HALF + m) * DFF + hc0 + 4 * n) = w;
                }
            }
        }
    }
};
}


struct Args { const float* in[33]; float* out; unsigned char* ws; int ph_lo, ph_hi, rep, pad; };
struct Frame { LAS unsigned char* lds; int tid, lane, wave, G, bid; };
constexpr int NWAVES = 8;

template <int MAP> __device__ __forceinline__ void transpose_item(const float* W, int K, int N, bf16_t* WT, const float* g, LAS float* scr, int item, int lane) {
    const int nblk = N / 32, kb = item / nblk, nb = item % nblk, k0 = 64 * kb, n0 = 32 * nb;
    int r0 = n0; if (MAP == 1) { const int c = n0 < DFF ? n0 : n0 - DFF; r0 = 256 * (c >> 7) + (c & 127) + (n0 < DFF ? 0 : 128); }
#pragma unroll 8
    for (int i = 0; i < 32; ++i) { const int kk = 2 * i + (lane >> 5); float v = W[(size_t)(k0 + kk) * N + n0 + (lane & 31)]; if (g) v *= g[k0 + kk]; scr[kk * 33 + (lane & 31)] = v; }
    LDS_WAIT(); asm volatile("" ::: "memory");
    const int c = lane & 7;
#pragma unroll
    for (int j = 0; j < 4; ++j) { const int n = (lane >> 3) + 8 * j; const LAS float* s = scr + (8 * c) * 33 + n;
        u32x4 o; o.x = cvt_pk_bf16(s[0 * 33], s[1 * 33]); o.y = cvt_pk_bf16(s[2 * 33], s[3 * 33]); o.z = cvt_pk_bf16(s[4 * 33], s[5 * 33]); o.w = cvt_pk_bf16(s[6 * 33], s[7 * 33]);
        *(u32x4*)(WT + (size_t)(r0 + n) * K + k0 + 8 * c) = o; }
    LDS_WAIT(); asm volatile("" ::: "memory");
}
template <int MAP> __device__ __forceinline__ void convert_items(const float* W, const int K, const int N, bf16_t* WT, const float* g, LAS float* scr, int it, const int it_end, const int it_stride, const int lane, const int col0 = 0, const int ncols = 0) {
    const int nblk = (ncols ? ncols : N) / 32;
    float va[32];
#define CV_LOAD(IT, V) do { const int kb_ = (IT) / nblk, nb_ = (IT) % nblk; const float* p_ = W + (size_t)(64 * kb_ + (lane >> 5)) * N + col0 + 32 * nb_ + (lane & 31); \
        _Pragma("unroll") for (int i = 0; i < 32; ++i) V[i] = __builtin_nontemporal_load(p_ + (size_t)(2 * i) * N); } while (0)
    if (it < it_end) CV_LOAD(it, va);
    while (it < it_end) {
        const int itn = it + it_stride;
        float vb[32];
        if (itn < it_end) CV_LOAD(itn, vb);
        const int kb = it / nblk, nb = it % nblk, k0 = 64 * kb, n0 = col0 + 32 * nb;
        int r0 = n0; if (MAP == 1) { const int c = n0 < DFF ? n0 : n0 - DFF; r0 = 256 * (c >> 7) + (c & 127) + (n0 < DFF ? 0 : 128); }
#pragma unroll
        for (int i = 0; i < 32; ++i) scr[(lane & 31) * 66 + 2 * i + (lane >> 5)] = va[i];
        LDS_WAIT(); asm volatile("" ::: "memory");
        const int c = lane & 7, nn = lane >> 3;
        f32x4 g0 = (f32x4){1.f, 1.f, 1.f, 1.f}, g1 = g0;
        if (g) { g0 = *(const f32x4*)(g + k0 + 8 * c); g1 = *(const f32x4*)(g + k0 + 8 * c + 4); }
#pragma unroll
        for (int j = 0; j < 4; ++j) { const int n = nn + 8 * j; const LAS f32x2* s = (const LAS f32x2*)(scr + n * 66 + 8 * c);
            const f32x2 a = s[0], b = s[1], d = s[2], e = s[3];
            u32x4 o; o.x = cvt_pk_bf16(a[0] * g0[0], a[1] * g0[1]); o.y = cvt_pk_bf16(b[0] * g0[2], b[1] * g0[3]); o.z = cvt_pk_bf16(d[0] * g1[0], d[1] * g1[1]); o.w = cvt_pk_bf16(e[0] * g1[2], e[1] * g1[3]);
            *(u32x4*)(WT + (size_t)(r0 + n) * K + k0 + 8 * c) = o; }
        LDS_WAIT(); asm volatile("" ::: "memory");
#pragma unroll
        for (int i = 0; i < 32; ++i) va[i] = vb[i];
        it = itn;
    }
#undef CV_LOAD
}
__device__ __forceinline__ unsigned pack4_i8(float a, float b, float c, float d) {
    const int ia = (int)__builtin_rintf(a), ib = (int)__builtin_rintf(b), ic = (int)__builtin_rintf(c), id = (int)__builtin_rintf(d);
    return ((unsigned)ia & 255u) | (((unsigned)ib & 255u) << 8) | (((unsigned)ic & 255u) << 16) | ((unsigned)id << 24);
}
__device__ __forceinline__ unsigned pack4_i8c(float a, float b, float c, float d) {
    int ia = (int)__builtin_rintf(a), ib = (int)__builtin_rintf(b), ic = (int)__builtin_rintf(c), id = (int)__builtin_rintf(d);
    ia = ia < -127 ? -127 : (ia > 127 ? 127 : ia); ib = ib < -127 ? -127 : (ib > 127 ? 127 : ib); ic = ic < -127 ? -127 : (ic > 127 ? 127 : ic); id = id < -127 ? -127 : (id > 127 ? 127 : id);
    return ((unsigned)ia & 255u) | (((unsigned)ib & 255u) << 8) | (((unsigned)ic & 255u) << 16) | ((unsigned)id << 24);
}
__device__ __forceinline__ void convert_items_i8(const float* W, const int K, const int N, signed char* WQ, const float* g, const float* wmax, LAS float* scr, int it, const int it_end, const int it_stride, const int lane) {
    const int nblk = N / 32;
    float va[32];
#define CV_LOAD(IT, V) do { const int kb_ = (IT) / nblk, nb_ = (IT) % nblk; const float* p_ = W + (size_t)(64 * kb_ + (lane >> 5)) * N + 32 * nb_ + (lane & 31); \
        _Pragma("unroll") for (int i = 0; i < 32; ++i) V[i] = __builtin_nontemporal_load(p_ + (size_t)(2 * i) * N); } while (0)
    if (it < it_end) CV_LOAD(it, va);
    while (it < it_end) {
        const int itn = it + it_stride;
        float vb[32];
        if (itn < it_end) CV_LOAD(itn, vb);
        const int kb = it / nblk, nb = it % nblk, k0 = 64 * kb, n0 = 32 * nb;
        const int c_ = n0 < DFF ? n0 : n0 - DFF; const int r0 = 256 * (c_ >> 7) + (c_ & 127) + (n0 < DFF ? 0 : 128);
#pragma unroll
        for (int i = 0; i < 32; ++i) scr[(lane & 31) * 66 + 2 * i + (lane >> 5)] = va[i];
        LDS_WAIT(); asm volatile("" ::: "memory");
        const int c = lane & 7, nn = lane >> 3;
        const f32x4 g0 = *(const f32x4*)(g + k0 + 8 * c), g1 = *(const f32x4*)(g + k0 + 8 * c + 4);
#pragma unroll
        for (int j = 0; j < 4; ++j) { const int n = nn + 8 * j; const LAS f32x2* s = (const LAS f32x2*)(scr + n * 66 + 8 * c);
            const f32x2 a = s[0], b = s[1], d = s[2], e = s[3];
            const float iw = 127.0f * __builtin_amdgcn_rcpf(fmaxf(wmax[n0 + n], 1e-30f));
            u32x2 o; o.x = pack4_i8(a[0] * g0[0] * iw, a[1] * g0[1] * iw, b[0] * g0[2] * iw, b[1] * g0[3] * iw); o.y = pack4_i8(d[0] * g1[0] * iw, d[1] * g1[1] * iw, e[0] * g1[2] * iw, e[1] * g1[3] * iw);
            *(u32x2*)(WQ + (size_t)(r0 + n) * K + k0 + 8 * c) = o; }
        LDS_WAIT(); asm volatile("" ::: "memory");
#pragma unroll
        for (int i = 0; i < 32; ++i) va[i] = vb[i];
        it = itn;
    }
#undef CV_LOAD
}
__device__ __forceinline__ void rms_row_to_bf16(const float* xrow, const float* g, bf16_t* orow, int lane) {
    const f32x4* xr = (const f32x4*)xrow + 2 * lane;
    f32x4 v[8][2]; float s = 0.f;
#pragma unroll
    for (int j = 0; j < 8; ++j) { v[j][0] = __builtin_nontemporal_load(xr + 128 * j); v[j][1] = __builtin_nontemporal_load(xr + 128 * j + 1);
        s += (v[j][0][0] * v[j][0][0] + v[j][0][1] * v[j][0][1]) + (v[j][0][2] * v[j][0][2] + v[j][0][3] * v[j][0][3]) + (v[j][1][0] * v[j][1][0] + v[j][1][1] * v[j][1][1]) + (v[j][1][2] * v[j][1][2] + v[j][1][3] * v[j][1][3]); }
    const float rs = __builtin_amdgcn_rsqf(wave_sum(s) * (1.f / DM) + RMS_EPS);
#pragma unroll
    for (int j = 0; j < 8; ++j) { const f32x4 g0 = ((const f32x4*)g)[2 * lane + 128 * j], g1 = ((const f32x4*)g)[2 * lane + 128 * j + 1];
        const f32x4 a = v[j][0] * rs * g0, b = v[j][1] * rs * g1;
        u32x4 w; w.x = cvt_pk_bf16(a[0], a[1]); w.y = cvt_pk_bf16(a[2], a[3]); w.z = cvt_pk_bf16(b[0], b[1]); w.w = cvt_pk_bf16(b[2], b[3]);
        ((u32x4*)orow)[lane + 64 * j] = w; }
}

__device__ __forceinline__ void rms_row_to_bf16_q8(const float* xrow, const float* g, bf16_t* orow, signed char* qrow, float* qscale, int lane) {
    const f32x4* xr = (const f32x4*)xrow + 2 * lane;
    f32x4 v[8][2]; float s = 0.f;
#pragma unroll
    for (int j = 0; j < 8; ++j) { v[j][0] = __builtin_nontemporal_load(xr + 128 * j); v[j][1] = __builtin_nontemporal_load(xr + 128 * j + 1);
        s += (v[j][0][0] * v[j][0][0] + v[j][0][1] * v[j][0][1]) + (v[j][0][2] * v[j][0][2] + v[j][0][3] * v[j][0][3]) + (v[j][1][0] * v[j][1][0] + v[j][1][1] * v[j][1][1]) + (v[j][1][2] * v[j][1][2] + v[j][1][3] * v[j][1][3]); }
    const float rs = __builtin_amdgcn_rsqf(wave_sum(s) * (1.f / DM) + RMS_EPS);
    unsigned mxb = 0u;
#pragma unroll
    for (int j = 0; j < 8; ++j) { const f32x4 g0 = ((const f32x4*)g)[2 * lane + 128 * j], g1 = ((const f32x4*)g)[2 * lane + 128 * j + 1];
        v[j][0] = v[j][0] * rs * g0; v[j][1] = v[j][1] * rs * g1;
        u32x4 w; w.x = cvt_pk_bf16(v[j][0][0], v[j][0][1]); w.y = cvt_pk_bf16(v[j][0][2], v[j][0][3]); w.z = cvt_pk_bf16(v[j][1][0], v[j][1][1]); w.w = cvt_pk_bf16(v[j][1][2], v[j][1][3]);
        ((u32x4*)orow)[lane + 64 * j] = w;
        { const u32x4 ua = __builtin_bit_cast(u32x4, v[j][0]) & 0x7fffffffu, ub = __builtin_bit_cast(u32x4, v[j][1]) & 0x7fffffffu;
          const unsigned m0 = ua.x > ua.y ? ua.x : ua.y, m1 = ua.z > ua.w ? ua.z : ua.w, m2 = ub.x > ub.y ? ub.x : ub.y, m3 = ub.z > ub.w ? ub.z : ub.w;
          const unsigned m01 = m0 > m1 ? m0 : m1, m23 = m2 > m3 ? m2 : m3, m4 = m01 > m23 ? m01 : m23; mxb = m4 > mxb ? m4 : mxb; } }
#pragma unroll
    for (int o = 1; o < 64; o <<= 1) { const unsigned t = (unsigned)__shfl_xor((int)mxb, o); mxb = t > mxb ? t : mxb; }
    const float mx = fmaxf(__builtin_bit_cast(float, mxb), 1e-30f), iq = 127.0f * __builtin_amdgcn_rcpf(mx);
#pragma unroll
    for (int j = 0; j < 8; ++j) { u32x2 o; o.x = pack4_i8c(v[j][0][0] * iq, v[j][0][1] * iq, v[j][0][2] * iq, v[j][0][3] * iq); o.y = pack4_i8c(v[j][1][0] * iq, v[j][1][1] * iq, v[j][1][2] * iq, v[j][1][3] * iq);
        ((u32x2*)qrow)[lane + 64 * j] = o; }
    if (lane == 0) *qscale = mx * (1.0f / 127.0f);
}
__device__ __forceinline__ void convert_colblock_i8(const float* W, const int ldw, const int c0, signed char* WQ, float* wmax_out, LAS unsigned char* lds, const int wave, const int lane) {
    LAS unsigned* cm = (LAS unsigned*)(lds + 131072);
    { const float* p = W + (size_t)(512 * wave + (lane >> 5)) * ldw + c0 + (lane & 31); unsigned m = 0u;
#pragma unroll 16
      for (int i = 0; i < 256; ++i) { const unsigned a = __builtin_bit_cast(unsigned, p[(size_t)(2 * i) * ldw]) & 0x7fffffffu; m = a > m ? a : m; }
      const unsigned t = (unsigned)__shfl_xor((int)m, 32); m = t > m ? t : m;
      if (lane < 32) cm[wave * 32 + lane] = m; }
    LDS_WAIT(); __syncthreads();
    if (wave == 0 && lane < 32) { unsigned m = 0u;
#pragma unroll
        for (int w = 0; w < 8; ++w) { const unsigned t = cm[w * 32 + lane]; m = t > m ? t : m; }
        cm[256 + lane] = m; wmax_out[lane] = __builtin_bit_cast(float, m); }
    LDS_WAIT(); __syncthreads();
    LAS float* scr = (LAS float*)(lds + wave * 16384);
    for (int kb = wave; kb < 64; kb += 8) {
        const float* p_ = W + (size_t)(64 * kb + (lane >> 5)) * ldw + c0 + (lane & 31);
        float va[32];
#pragma unroll
        for (int i = 0; i < 32; ++i) va[i] = p_[(size_t)(2 * i) * ldw];
#pragma unroll
        for (int i = 0; i < 32; ++i) scr[(lane & 31) * 66 + 2 * i + (lane >> 5)] = va[i];
        LDS_WAIT(); asm volatile("" ::: "memory");
        const int c = lane & 7, nn = lane >> 3;
#pragma unroll
        for (int j = 0; j < 4; ++j) { const int n = nn + 8 * j; const LAS f32x2* s = (const LAS f32x2*)(scr + n * 66 + 8 * c);
            const f32x2 a = s[0], b = s[1], d = s[2], e = s[3];
            const float iw = 127.0f * __builtin_amdgcn_rcpf(fmaxf(__builtin_bit_cast(float, cm[256 + n]), 1e-30f));
            u32x2 o; o.x = pack4_i8c(a[0] * iw, a[1] * iw, b[0] * iw, b[1] * iw); o.y = pack4_i8c(d[0] * iw, d[1] * iw, e[0] * iw, e[1] * iw);
            *(u32x2*)(WQ + (size_t)n * 4096 + 64 * kb + 8 * c) = o; }
        LDS_WAIT(); asm volatile("" ::: "memory");
    }
    __syncthreads();
}
enum { I_XP = 0, I_XS, I_MP, I_MS, I_NMIX, I_WIN, I_MU, I_LNG, I_LNB, I_WS, I_BS, I_W0, I_WDEC, I_A0, I_WICLR, I_WGATE, I_KK, I_KA, I_RK, I_GNG, I_GNB, I_WOUT, I_NX, I_NMEM, I_WQ, I_WKV, I_WO, I_NFFN, I_WUP, I_CW, I_CB, I_WDOWN, I_NOUT };

#define KARG_PTRS ((const float* const __attribute__((address_space(4)))*)__builtin_amdgcn_kernarg_segment_ptr())
#define ARGIN(k) (KARG_PTRS[(k)])
#define ARG_OUT ((float*)KARG_PTRS[33])
#define ARG_WS ((unsigned char*)KARG_PTRS[34])
#define ARG_INT(i) (((const int __attribute__((address_space(4)))*)__builtin_amdgcn_kernarg_segment_ptr())[70 + (i)])
__global__ void __launch_bounds__(NWAVES * 64, 2) fwd(Args) {
    extern __shared__ __attribute__((aligned(16))) unsigned char lds_raw[];
    Frame F; F.lds = (LAS unsigned char*)lds_raw; F.tid = threadIdx.x; F.lane = F.tid & 63; F.wave = __builtin_amdgcn_readfirstlane(F.tid >> 6); F.G = gridDim.x; F.bid = blockIdx.x;
    volatile LAS unsigned* MISC = (volatile LAS unsigned*)(F.lds + MISC_OFF);
    unsigned char* ws = ARG_WS;
    unsigned* ctl = (unsigned*)(ws + WS_CTL);
    for (int u = F.tid; u < 64; u += NWAVES * 64) MISC[u] = 0u;
    __syncthreads();
    const int lo = ARG_INT(0), hi = ARG_INT(1);
    const int rep = ARG_INT(2);
    const bool multi = (hi - lo) > 1;
    XcdBarrier bar; bar.bar = ctl + CW_BAR; bar.x = 0; bar.st = nullptr;
    if (multi) bar = xcd_barrier_post(ctl + CW_BAR, MISC + 8);
#ifndef PH_MASK
#define PH_MASK 0x1ffff
#endif
#define IN(k) ((((PH_MASK) >> (k)) & 1) && lo <= (k) && (k) < hi)
#define SEAM(k) do { if (IN((k) + 1)) xcd_barrier(bar); } while (0)
    LAS float* xs = (LAS float*)(F.lds + XS_OFF);
    const int gw = F.bid * NWAVES + F.wave, NGW = F.G * NWAVES;
    float* ss1 = (float*)(ctl + CW_SS); float* ss2 = ss1 + MTOK; float* ss3 = ss2 + MTOK; float* ssd = ss3 + MTOK;
    bf16_t* Wt_in = (bf16_t*)(ws + WS_WIN); bf16_t* Wt_down = (bf16_t*)(ws + WS_WIN); bf16_t* Wt_out = (bf16_t*)(ws + WS_WOUT); bf16_t* Wt_q = (bf16_t*)(ws + WS_WQ);
    bf16_t* Wt_kv = (bf16_t*)(ws + WS_WKV); bf16_t* Wt_o = (bf16_t*)(ws + WS_WO); bf16_t* Wt_gate = (bf16_t*)(ws + WS_WGATE); bf16_t* Wt_lora = (bf16_t*)(ws + WS_WLORA);
    bf16_t* A_lora = (bf16_t*)(ws + WS_ALORA); bf16_t* A_gate = (bf16_t*)(ws + WS_AGATE); float* ZBf = (float*)(ws + WS_ZB);
    bf16_t* memn = (bf16_t*)(ws + WS_MEMN); bf16_t* KVB = (bf16_t*)(ws + WS_KB);
    bf16_t* WQR = (bf16_t*)(ws + WS_WQ);
    bf16_t* KWt = (bf16_t*)(ws + WS_Z); bf16_t* VWt = (bf16_t*)(ws + WS_Z + 64 * MiB);
    float* SBN = (float*)(ws + WS_SB);
    bf16_t* H0 = (bf16_t*)(ws + WS_H); bf16_t* YF = (bf16_t*)(ws + WS_H); bf16_t* X1B = (bf16_t*)(ws + WS_H);
    bf16_t* CAT = (bf16_t*)(ws + WS_C); signed char* WupQ = (signed char*)(ws + WS_C);
    signed char* X2Q = (signed char*)(ws + WS_G);
    float* zsc = (float*)(ctl + CW_ZS); float* wmaxf = (float*)(ctl + CW_WMAX);
    signed char* H0Q = (signed char*)(ws + WS_G);
    signed char* WinQ = (signed char*)(ws + WS_C);
    bf16_t* GB = (bf16_t*)(ws + WS_G); bf16_t* PB = (bf16_t*)(ws + WS_G);
    bf16_t* ZA = (bf16_t*)(ws + WS_Z); bf16_t* ZL = (bf16_t*)(ws + WS_Z + 192 * MiB); bf16_t* ZH = (bf16_t*)(ws + WS_Z + 228 * MiB); bf16_t* ACT = (bf16_t*)(ws + WS_Z);
    bf16_t* LORA = (bf16_t*)ARG_OUT;

    if (IN(0)) {
        LAS float* scr = (LAS float*)(F.lds + F.wave * 16384);
        constexpr int I_IN = 64 * (INC / 32), I_GT = 8 * (2048 / 32);
        for (int cb = (I8_LO - 16) * 8 + F.bid; cb < (I8_HI - 16) * 8; cb += F.G) convert_colblock_i8(ARGIN(I_WIN), INC, ZB0 + 32 * cb, WinQ + (size_t)(32 * cb) * DM, (float*)(ctl + CW_WMIN) + 32 * cb, F.lds, F.wave, F.lane);
        convert_items<0>(ARGIN(I_WIN), DM, INC, Wt_in, nullptr, scr, gw, 64 * (I8_LO * 256 / 32), NGW, F.lane, 0, I8_LO * 256);
        convert_items<0>(ARGIN(I_WIN), DM, INC, Wt_in, nullptr, scr, gw, 64 * ((INC - I8_HI * 256) / 32), NGW, F.lane, I8_HI * 256, INC - I8_HI * 256);
        convert_items<0>(ARGIN(I_WGATE), 512, 2048, Wt_gate, nullptr, scr, gw, I_GT, NGW, F.lane);
        for (int i = F.bid * 512 + F.tid; i < 8192 * 32; i += F.G * 512) {
            const int n = i & 8191, k8 = i >> 13, bq = n >> 11, c = n & 2047, k0 = 8 * k8;
            float f[8];
#pragma unroll
            for (int j = 0; j < 8; ++j) { const int k = k0 + j; float v = 0.f;
                if (bq < 2) { if (k < 128) v = ARGIN(I_WDEC)[((size_t)bq * 128 + k) * 2048 + c]; }
                else { if (k >= 128) v = ARGIN(I_WICLR)[((size_t)(bq - 2) * 128 + (k - 128)) * 2048 + c]; }
                f[j] = v; }
            *(u32x4*)(Wt_lora + (size_t)n * 256 + k0) = pack8(f);
        }
        for (int m = gw; m < MTOK; m += NGW) rms_row_to_bf16_q8(m < NTP ? ARGIN(I_XP) + (size_t)m * DM : ARGIN(I_XS) + (size_t)(m - NTP) * DM, ARGIN(I_NMIX), H0 + (size_t)m * DM, H0Q + (size_t)m * DM, (float*)(ctl + CW_RS0) + m, F.lane);
        for (int m = gw; m < 2048; m += NGW) rms_row_to_bf16(m < 1024 ? ARGIN(I_MP) + (size_t)m * DM : ARGIN(I_MS) + (size_t)(m - 1024) * DM, ARGIN(I_NMEM), memn + (size_t)m * DM, F.lane);
        SEAM(0);
    }
    if (IN(1)) {
        struct SchedZ { const char* A; const char* B; int lda, nT, lo, skip, brow0, G, c;
            __device__ __forceinline__ bool next(int i, pg8::Unit& u) const {
                const long L = (long)i * G + c; if (L >= (long)96 * nT) return false;
                int j; pg8::tile_order((int)L, 96, nT, u.pm, j); u.pn = j < lo ? j : j + skip; u.z = 0; u.pad = 0;
                u.A = A + (size_t)u.pm * 256 * lda * 2; u.B = B + (size_t)(u.pn - brow0) * 256 * lda * 2; return true; } };
        pg8::EpiBf16<1> E{ZA, DM, nullptr, nullptr, (const float*)(ctl + CW_RS0), (const float*)(ctl + CW_WMIN), (float*)(ctl + CW_LN), ZH, ZL};
        {
            SchedZ S8{(const char*)H0Q, (const char*)WinQ, DM / 2, I8_HI - I8_LO, 0, I8_LO, 16, F.G, F.bid};
            pg8::gemm_phase<pg8::EpiBf16<1>, SchedZ, true, true, true>(F.lds, DM / 2, DM / 2, DM / 2, S8, E); }
        SchedZ S{(const char*)H0, (const char*)Wt_in, DM, INC / 256 - (I8_HI - I8_LO), I8_LO, I8_HI - I8_LO, 0, F.G, F.bid};
        pg8::gemm_phase<pg8::EpiBf16<1>, SchedZ, true, true>(F.lds, DM, DM, DM, S, E);
        {
            const int nun = (MTOK / 256) * (INC / 256 - (I8_HI - I8_LO)), rounds = (nun + F.G - 1) / F.G, nbusy = nun - (rounds - 1) * F.G;
            const int nidle = F.G - nbusy;
            LAS float* scr = (LAS float*)(F.lds + F.wave * 16384);
            constexpr int I_SQ = 64 * (DM / 32), I_KV = 64 * (2 * DM / 32);
            const int w0 = (nidle > 0) ? ((F.bid - nbusy) * NWAVES + F.wave) : gw, nw = (nidle > 0) ? nidle * NWAVES : NGW;
            if (nidle == 0 || F.bid >= nbusy) {
                convert_items<0>(ARGIN(I_WOUT), DM, DM, Wt_out, nullptr, scr, w0, I_SQ, nw, F.lane);
                { const float* wq = ARGIN(I_WQ); const float* nx = ARGIN(I_NX);
                  const int t0_ = (nidle > 0) ? (F.bid - nbusy) * 512 + F.tid : F.bid * 512 + F.tid, tn_ = (nidle > 0) ? nidle * 512 : F.G * 512;
                  for (int i = t0_; i < DM * DM / 8; i += tn_) { const float g_ = nx[i >> 9]; const f32x4 a = __builtin_nontemporal_load((const f32x4*)wq + 2 * i) * g_, b = __builtin_nontemporal_load((const f32x4*)wq + 2 * i + 1) * g_;
                      u32x4 w; w.x = cvt_pk_bf16(a[0], a[1]); w.y = cvt_pk_bf16(a[2], a[3]); w.z = cvt_pk_bf16(b[0], b[1]); w.w = cvt_pk_bf16(b[2], b[3]); ((u32x4*)WQR)[i] = w; } }
                convert_items<0>(ARGIN(I_WKV), DM, 2 * DM, Wt_kv, nullptr, scr, w0, I_KV, nw, F.lane);
                convert_items<0>(ARGIN(I_WO), DM, DM, Wt_o, nullptr, scr, w0, I_SQ, nw, F.lane);
            }
        }
        SEAM(1);
    }
    if (IN(2)) {
        const float* mu = ARGIN(I_MU);
        {   constexpr int NIT = MTOK * 96; const int stride = F.G * 512;
            for (int base = F.bid * 512 + F.tid; base < NIT; base += 4 * stride) {
                u32x4 C[4], P[4], N[4]; f32x4 M0[4], M1[4];
#pragma unroll
                for (int k = 0; k < 4; ++k) { const int i_ = base + k * stride, i = i_ < NIT ? i_ : NIT - 1; const int row = i / 96, o = i - row * 96;
                    const int s0 = seq_start_of_row(row), T = seq_len_of_row(row), t = row - s0;
                    const bf16_t* zp = ZL + (size_t)row * 768 + 8 * o;
                    C[k] = *(const u32x4*)zp; P[k] = *(const u32x4*)(zp - (t > 0 ? 768 : 0)); N[k] = *(const u32x4*)(zp + (t < T - 1 ? 768 : 0));
                    M0[k] = *(const f32x4*)(mu + 6144 + 8 * o); M1[k] = *(const f32x4*)(mu + 6144 + 8 * o + 4); }
#pragma unroll
                for (int k = 0; k < 4; ++k) { const int i = base + k * stride; const int ic = i < NIT ? i : NIT - 1; const int row = ic / 96, o = ic - row * 96;
                    const int s0 = seq_start_of_row(row), T = seq_len_of_row(row), t = row - s0;
                    float c[8], p[8], n[8]; unpack8(C[k], c);
                    { u32x4 wp = P[k], wn = N[k]; if (!(t > 0)) wp = (u32x4){0u, 0u, 0u, 0u}; if (!(t < T - 1)) wn = (u32x4){0u, 0u, 0u, 0u}; unpack8(wp, p); unpack8(wn, n); }
                    float f[8];
#pragma unroll
                    for (int j = 0; j < 8; ++j) { const float m_ = j < 4 ? M0[k][j & 3] : M1[k][j & 3]; const float v = c[j] + m_ * (0.5f * (p[j] + n[j]) - c[j]);
                        f[j] = o < 16 ? tanhf_(v) : (o < 32 ? v : sigmoidf_(v)); }
                    if (i < NIT) { if (o < 32) *(u32x4*)(A_lora + (size_t)row * 256 + 8 * o) = pack8(f); else *(u32x4*)(A_gate + (size_t)row * 512 + 8 * (o - 32)) = pack8(f); }
                }
            }
        }
        {
            const float* wu = ARGIN(I_WUP); const float* nf = ARGIN(I_NFFN);
            if (F.G != 256)
            for (int it = gw; it < (NUP / 256) * 64; it += NGW) { const int nb = it % (NUP / 256), ks = it / (NUP / 256); unsigned m0 = 0u, m1 = 0u, m2 = 0u, m3 = 0u;
                const float* p = wu + (size_t)(ks * 64) * NUP + 256 * nb + 4 * F.lane;
#pragma unroll 16
                for (int k = 0; k < 64; ++k) { const f32x4 w4 = *(const f32x4*)(p + (size_t)k * NUP); const float g_ = nf[ks * 64 + k];
                    const unsigned b0 = __builtin_bit_cast(unsigned, w4[0] * g_) & 0x7fffffffu, b1 = __builtin_bit_cast(unsigned, w4[1] * g_) & 0x7fffffffu, b2 = __builtin_bit_cast(unsigned, w4[2] * g_) & 0x7fffffffu, b3 = __builtin_bit_cast(unsigned, w4[3] * g_) & 0x7fffffffu;
                    m0 = b0 > m0 ? b0 : m0; m1 = b1 > m1 ? b1 : m1; m2 = b2 > m2 ? b2 : m2; m3 = b3 > m3 ? b3 : m3; }
                unsigned* dst = (unsigned*)(ctl + CW_WMAX) + 256 * nb + 4 * F.lane;
                atomicMax(dst + 0, m0); atomicMax(dst + 1, m1); atomicMax(dst + 2, m2); atomicMax(dst + 3, m3); }
        }
        SEAM(2);
    }
    if (IN(3)) {
        pg8::SchedGrid S{(const char*)A_lora, (const char*)Wt_lora, 256, 256, MTOK / 256, 32, F.G, F.bid};
        pg8::EpiBf16<2> E{LORA, 8192, ARGIN(I_W0), ARGIN(I_A0), nullptr, nullptr, nullptr, nullptr, nullptr};
        pg8::gemm_phase<pg8::EpiBf16<2>, pg8::SchedGrid, true, true>(F.lds, 256, 256, 256, S, E);
        SEAM(3);
    }
    if (IN(4)) {
        constexpr int TC = 16, SM_LD = 136, TR_LD = 40;
        constexpr int OFF_AH = 0, OFF_RH = 2176, OFF_BH = 4352, OFF_KH = 6528, OFF_PH = 8704, OFF_QH = 10880, OFF_BT = 13056, OFF_KT = OFF_BT + 2560, OFF_VT = OFF_KT + 2560, OFF_CL = OFF_VT + 2560, IB_BYTES = OFF_CL + 256;
        typedef short bf16x4 __attribute__((ext_vector_type(4)));
#define CVT4(v) __builtin_bit_cast(bf16x4, (u32x2){cvt_pk_bf16((v)[0], (v)[1]), cvt_pk_bf16((v)[2], (v)[3])})
#define CAT8(lo, hi) __builtin_shufflevector((lo), (hi), 0, 1, 2, 3, 4, 5, 6, 7)
#define MFMA32(a, b, c) __builtin_amdgcn_mfma_f32_16x16x32_bf16((a), (b), (c), 0, 0, 0)
#define MFMA16(a, b, c) __builtin_amdgcn_mfma_f32_16x16x16bf16_1k((a), (b), (c), 0, 0, 0)
        const int role = F.wave >> 2, w4 = F.wave & 3, fr = F.lane & 15, fq = F.lane >> 4;
        const f32x4 zero4 = (f32x4){0.f, 0.f, 0.f, 0.f};
        const bool abs_in_scan = (F.G == 256);
        const int awv = F.bid * 4 + (F.wave & 3), acb = awv % (NUP / 256), arow0 = (awv / (NUP / 256)) * 373;
        const float* wabs = ARGIN(I_WUP) + 256 * acb + 4 * F.lane; const float* nfa = ARGIN(I_NFFN);
        unsigned am0 = 0u, am1 = 0u, am2 = 0u, am3 = 0u;
        for (int id2 = 2 * F.bid; id2 < 512; id2 += 2 * F.G) for (int item = 0; item < 2; ++item) {
            const int id = id2 >> 1;
            const int seq = (item == 0 ? 0 : 4) + (id >> 6), hd = id & 63, h = hd >> 1, dir = hd & 1;
            const int T = item == 0 ? 4096 : 2048, s0 = seq_start(seq);
            const int nch = T / TC;
            LAS unsigned char* ibase = F.lds;
            LAS bf16_t* ybase = (LAS bf16_t*)(F.lds + 2 * IB_BYTES);
            LAS float* rhoS = (LAS float*)(F.lds + 2 * IB_BYTES + 4096) + w4 * 16;
            const int ch = h * 64 + F.lane;
            const float mu_r = ARGIN(I_MU)[ch], mu_k = ARGIN(I_MU)[2048 + ch], mu_v = ARGIN(I_MU)[4096 + ch];
            const float kkc = ARGIN(I_KK)[ch], kac = ARGIN(I_KA)[ch], rkc = ARGIN(I_RK)[ch];
            f32x4 S[4] = {zero4, zero4, zero4, zero4};
            bf16_t* Yd = YF + (size_t)dir * MTOK * 2048;
            float* SBd = SBN + (size_t)dir * MTOK * NH;
            const int sgn = dir ? -1 : 1;
            unsigned eoff[16], zoff[6];
#pragma unroll
            for (int s = 0; s < 16; ++s) eoff[s] = (unsigned)((dir ? 15 - s : s) * 128 + F.lane * 2);
#pragma unroll
            for (int k = 0; k < 6; ++k) zoff[k] = (unsigned)((dir ? 5 - k : k) * 128 + F.lane * 2);
#define SCAN_ISSUE(CH, ER, AR, ZR) do { const int chc_ = (CH) < nch ? (CH) : nch - 1; const int cb_ = chc_ * TC; const int tq_ = dir ? (T - 1 - (cb_ + 4 * w4)) : (cb_ + 4 * w4); \
                    const char* eb_ = (const char*)(LORA + ((size_t)(dir * 32 + h) * MTOK + s0 + (dir ? T - 1 - cb_ - 15 : cb_)) * 64); \
                    const char* ab_ = (const char*)(LORA + ((size_t)((2 + dir) * 32 + h) * MTOK + s0 + (dir ? tq_ - 3 : tq_)) * 64); \
                    const char* zb0_ = (const char*)(ZH + ((ptrdiff_t)h * MTOK + s0 + (dir ? tq_ - 4 : tq_ - 1)) * 64); \
                    const char* zb1_ = zb0_ + (size_t)32 * MTOK * 128; const char* zb2_ = zb0_ + (size_t)64 * MTOK * 128; \
                    _Pragma("unroll") for (int s = 0; s < 16; ++s) ER[s] = (unsigned)*(const bf16_t*)(eb_ + eoff[s]); \
                    _Pragma("unroll") for (int q = 0; q < 4; ++q) AR[q] = (unsigned)*(const bf16_t*)(ab_ + eoff[dir ? q + 12 : q]); \
                    _Pragma("unroll") for (int k = 0; k < 6; ++k) { ZR[k][0] = (unsigned)*(const bf16_t*)(zb0_ + zoff[k]); ZR[k][1] = (unsigned)*(const bf16_t*)(zb1_ + zoff[k]); ZR[k][2] = (unsigned)*(const bf16_t*)(zb2_ + zoff[k]); } } while (0)
#define SCAN_BAR() do { LDS_WAIT(); __builtin_amdgcn_s_barrier(); asm volatile("" ::: "memory"); } while (0)
#define SCAN_PREP(CEXPR) do { const int c = (CEXPR); const bool do_prep = true; \
                if (do_prep) { \
                    const int tt0 = dir ? (T - 1 - ((c + 1) * TC + 4 * w4)) : ((c + 1) * TC + 4 * w4); \
                    LAS unsigned char* ibn = ibase + ((c + 1) & 1) * IB_BYTES; \
                    float cum = 0.f, cumq[4], eq[4]; \
_Pragma("unroll") \
                    for (int s = 0; s < 16; ++s) { const float ev = EF[s]; cum += ev; if ((s >> 2) == w4) { cumq[s & 3] = cum; eq[s & 3] = ev; } } \
                    float bt[4], kt[4], vt[4]; \
_Pragma("unroll") \
                    for (int q = 0; q < 4; ++q) { \
                        const int tp = tt0 + sgn * (q - 1), tn = tt0 + sgn * (q + 1); \
                        const bool okp = (tp >= 0 && tp < T), okn = (tn >= 0 && tn < T); \
                        const float rc = ZF[q + 1][0], kc = ZF[q + 1][1], vc = ZF[q + 1][2]; \
                        const float r_ = rc + mu_r * (0.5f * ((okp ? ZF[q][0] : 0.f) + (okn ? ZF[q + 2][0] : 0.f)) - rc); \
                        const float k_ = kc + mu_k * (0.5f * ((okp ? ZF[q][1] : 0.f) + (okn ? ZF[q + 2][1] : 0.f)) - kc); \
                        const float v_ = vc + mu_v * (0.5f * ((okp ? ZF[q][2] : 0.f) + (okn ? ZF[q + 2][2] : 0.f)) - vc); \
                        const float a_ = AF[q]; \
                        const float kk = k_ * kkc; \
                        const float kd = k_ * (1.0f + (a_ - 1.0f) * kac); \
                        const float ict = fexp(cumq[q]), ct = fexp(-cumq[q]), cprev = fexp(eq[q] - cumq[q]); \
                        const int ts = 4 * w4 + q; \
                        *(LAS bf16_t*)(ibn + OFF_AH + ts * SM_LD + F.lane * 2) = (bf16_t)(cvt_pk_bf16(-cprev * kk, 0.f) & 0xffffu); \
                        *(LAS bf16_t*)(ibn + OFF_RH + ts * SM_LD + F.lane * 2) = (bf16_t)(cvt_pk_bf16(ct * r_, 0.f) & 0xffffu); \
                        *(LAS bf16_t*)(ibn + OFF_PH + ts * SM_LD + F.lane * 2) = (bf16_t)(cvt_pk_bf16(kk, 0.f) & 0xffffu); \
                        *(LAS bf16_t*)(ibn + OFF_QH + ts * SM_LD + F.lane * 2) = (bf16_t)(cvt_pk_bf16(ct * r_ * rkc, 0.f) & 0xffffu); \
                        bt[q] = kk * a_ * ict; kt[q] = kd * ict; vt[q] = v_; \
                        *(LAS bf16_t*)(ibn + OFF_BH + ts * SM_LD + F.lane * 2) = (bf16_t)(cvt_pk_bf16(bt[q], 0.f) & 0xffffu); \
                        *(LAS bf16_t*)(ibn + OFF_KH + ts * SM_LD + F.lane * 2) = (bf16_t)(cvt_pk_bf16(kt[q], 0.f) & 0xffffu); \
                        if (ts == 15) *(LAS float*)(ibn + OFF_CL + F.lane * 4) = ct; \
                    } \
                    *(LAS u32x2*)(ibn + OFF_BT + F.lane * TR_LD + w4 * 8) = (u32x2){cvt_pk_bf16(bt[0], bt[1]), cvt_pk_bf16(bt[2], bt[3])}; \
                    *(LAS u32x2*)(ibn + OFF_KT + F.lane * TR_LD + w4 * 8) = (u32x2){cvt_pk_bf16(kt[0], kt[1]), cvt_pk_bf16(kt[2], kt[3])}; \
                    *(LAS u32x2*)(ibn + OFF_VT + F.lane * TR_LD + w4 * 8) = (u32x2){cvt_pk_bf16(vt[0], vt[1]), cvt_pk_bf16(vt[2], vt[3])}; \
                } \
            } while (0)
#define SCAN_RUN(CEXPR) do { const int c = (CEXPR); const bool do_run = true; \
                if (do_run) { \
                    const LAS unsigned char* ib = ibase + (c & 1) * IB_BYTES; \
                    bf16x8 Aop[2], Rop[2], Bop[2], Kop[2]; \
_Pragma("unroll") \
                    for (int kb = 0; kb < 2; ++kb) { const int o = fr * SM_LD + (32 * kb + 4 * fq) * 2; \
                        Aop[kb] = CAT8(*(const LAS bf16x4*)(ib + OFF_AH + o), *(const LAS bf16x4*)(ib + OFF_AH + o + 32)); \
                        Rop[kb] = CAT8(*(const LAS bf16x4*)(ib + OFF_RH + o), *(const LAS bf16x4*)(ib + OFF_RH + o + 32)); \
                        Bop[kb] = CAT8(*(const LAS bf16x4*)(ib + OFF_BH + o), *(const LAS bf16x4*)(ib + OFF_BH + o + 32)); \
                        Kop[kb] = CAT8(*(const LAS bf16x4*)(ib + OFF_KH + o), *(const LAS bf16x4*)(ib + OFF_KH + o + 32)); } \
                    f32x4 Dk = zero4, Db = zero4; \
_Pragma("unroll") \
                    for (int kb = 0; kb < 2; ++kb) { const int o = fr * SM_LD + (32 * kb + 4 * fq) * 2; \
                        const bf16x8 Pop = CAT8(*(const LAS bf16x4*)(ib + OFF_PH + o), *(const LAS bf16x4*)(ib + OFF_PH + o + 32)), Qop = CAT8(*(const LAS bf16x4*)(ib + OFF_QH + o), *(const LAS bf16x4*)(ib + OFF_QH + o + 32)); \
                        Dk = MFMA32(Pop, Pop, Dk); Db = MFMA32(Qop, Kop[kb], Db); } \
                    { const int e_ = fr & 3; const float dk = e_ == 0 ? Dk[0] : (e_ == 1 ? Dk[1] : (e_ == 2 ? Dk[2] : Dk[3])), db = e_ == 0 ? Db[0] : (e_ == 1 ? Db[1] : (e_ == 2 ? Db[2] : Db[3])); \
                      if (fq == (fr >> 2)) { rhoS[fr] = __builtin_amdgcn_rsqf(fmaxf(dk, L2_EPS)); \
                          if (w4 == 0) { const int st_ = c * TC + fr; SBd[(size_t)(s0 + (dir ? T - 1 - st_ : st_)) * NH + h] = db; } } } \
                    LDS_WAIT(); asm volatile("" ::: "memory"); \
                    const float rho_fr = rhoS[fr]; const f32x4 rho4 = *(const LAS f32x4*)(rhoS + 4 * fq); \
                    const bf16x4 v4 = *(const LAS bf16x4*)(ib + OFF_VT + (16 * w4 + fr) * TR_LD + fq * 8); \
                    f32x4 Nacc = zero4, Macc = zero4, NRacc = zero4, MRacc = zero4, NTacc = zero4; \
_Pragma("unroll") \
                    for (int kb = 0; kb < 2; ++kb) { Nacc = MFMA32(Bop[kb], Aop[kb], Nacc); Macc = MFMA32(Kop[kb], Aop[kb], Macc); NRacc = MFMA32(Bop[kb], Rop[kb], NRacc); \
                        MRacc = MFMA32(Kop[kb], Rop[kb], MRacc); NTacc = MFMA32(Aop[kb], Bop[kb], NTacc); } \
                    f32x4 Tm; \
_Pragma("unroll") \
                    for (int e = 0; e < 4; ++e) { const int m = 4 * fq + e; \
                        Nacc[e] = m < fr ? Nacc[e] * (rho4[e] * rho_fr) : 0.f; Macc[e] = m < fr ? Macc[e] * rho_fr : 0.f; NRacc[e] = m <= fr ? NRacc[e] : 0.f; MRacc[e] = m <= fr ? MRacc[e] : 0.f; NTacc[e] = fr < m ? NTacc[e] * (rho4[e] * rho_fr) : 0.f; \
                        Tm[e] = Nacc[e] + (m == fr ? 1.f : 0.f); } \
                    const bf16x4 n4 = CVT4(Nacc), nt4 = CVT4(NTacc); \
                    const f32x4 P1 = MFMA16(nt4, n4, zero4), P1T = MFMA16(n4, nt4, zero4); \
                    const bf16x4 p1 = CVT4(P1), p1t = CVT4(P1T); \
                    Tm = MFMA16(p1t, CVT4(Tm), Tm); \
                    const f32x4 P2 = MFMA16(p1t, p1, zero4), P2T = MFMA16(p1, p1t, zero4); \
                    const bf16x4 p2 = CVT4(P2), p2t = CVT4(P2T); \
                    Tm = MFMA16(p2t, CVT4(Tm), Tm); \
                    const f32x4 P3T = MFMA16(p2, p2t, zero4); \
                    Tm = MFMA16(CVT4(P3T), CVT4(Tm), Tm); \
                    bf16x8 Sop[2]; \
_Pragma("unroll") \
                    for (int kb = 0; kb < 2; ++kb) Sop[kb] = CAT8(CVT4(S[2 * kb]), CVT4(S[2 * kb + 1])); \
                    f32x4 X = zero4, YR = zero4; \
_Pragma("unroll") \
                    for (int kb = 0; kb < 2; ++kb) { X = MFMA32(Aop[kb], Sop[kb], X); YR = MFMA32(Rop[kb], Sop[kb], YR); } \
                    const f32x4 W1 = MFMA16(CVT4(Macc), v4, X * rho4); \
                    const f32x4 U = MFMA16(CVT4(Tm), CVT4(W1), zero4) * rho4; \
                    const bf16x8 uv = CAT8(CVT4(U), v4); \
                    const f32x4 Y = MFMA32(CAT8(CVT4(NRacc), CVT4(MRacc)), uv, YR); \
_Pragma("unroll") \
                    for (int jt = 0; jt < 4; ++jt) { const int j = 16 * jt + fr; \
                        const bf16x8 bk = CAT8(*(const LAS bf16x4*)(ib + OFF_BT + j * TR_LD + fq * 8), *(const LAS bf16x4*)(ib + OFF_KT + j * TR_LD + fq * 8)); \
                        S[jt] = MFMA32(bk, uv, S[jt]); \
                        S[jt] = S[jt] * *(const LAS f32x4*)(ib + OFF_CL + (16 * jt + 4 * fq) * 4); } \
                    LAS bf16_t* yb = ybase + (c & 1) * (TC * 64); \
_Pragma("unroll") \
                    for (int e = 0; e < 4; ++e) yb[(4 * fq + e) * 64 + 16 * w4 + fr] = (bf16_t)(cvt_pk_bf16(Y[e], 0.f) & 0xffffu); \
                } \
            } while (0)
#define SCAN_FLUSH(CEXPR) do { const int c = (CEXPR); const bool do_run = true; \
                if (do_run) { \
                    const LAS bf16_t* yb = ybase + (c & 1) * (TC * 64); \
_Pragma("unroll") \
                    for (int q = 0; q < 4; ++q) { const int st = c * TC + 4 * w4 + q; const int t = dir ? (T - 1 - st) : st; \
                        Yd[(size_t)(s0 + t) * 2048 + ch] = yb[(4 * w4 + q) * 64 + F.lane]; } \
                } \
            } while (0)
            if (role == 1) {
                unsigned er[16], ar[4], zr[6][3];
                SCAN_ISSUE(0, er, ar, zr);
                const int kbase = item ? 256 : 0;
#define ABS_ROW(k) (min(arow0 + min((k), 372), DM - 1))
                f32x4 wq = *(const f32x4*)(wabs + (size_t)ABS_ROW(kbase) * NUP); float gq = nfa[ABS_ROW(kbase)];
                for (int cp = -1; cp < nch - 1; ++cp) {
                    float EF[16], AF[4], ZF[6][3];
#pragma unroll
                    for (int s = 0; s < 16; ++s) EF[s] = bf2f((bf16_t)er[s]);
#pragma unroll
                    for (int q = 0; q < 4; ++q) AF[q] = bf2f((bf16_t)ar[q]);
#pragma unroll
                    for (int k = 0; k < 6; ++k) { ZF[k][0] = bf2f((bf16_t)zr[k][0]); ZF[k][1] = bf2f((bf16_t)zr[k][1]); ZF[k][2] = bf2f((bf16_t)zr[k][2]); }
                    asm volatile("" : "+v"(EF[0]), "+v"(EF[1]), "+v"(EF[2]), "+v"(EF[3]), "+v"(EF[4]), "+v"(EF[5]), "+v"(EF[6]), "+v"(EF[7]), "+v"(EF[8]), "+v"(EF[9]), "+v"(EF[10]), "+v"(EF[11]),
                                 "+v"(EF[12]), "+v"(EF[13]), "+v"(EF[14]), "+v"(EF[15]), "+v"(AF[0]), "+v"(AF[1]), "+v"(AF[2]), "+v"(AF[3]) :: "memory");
                    asm volatile("" : "+v"(ZF[0][0]), "+v"(ZF[0][1]), "+v"(ZF[0][2]), "+v"(ZF[1][0]), "+v"(ZF[1][1]), "+v"(ZF[1][2]), "+v"(ZF[2][0]), "+v"(ZF[2][1]), "+v"(ZF[2][2]),
                                 "+v"(ZF[3][0]), "+v"(ZF[3][1]), "+v"(ZF[3][2]), "+v"(ZF[4][0]), "+v"(ZF[4][1]), "+v"(ZF[4][2]), "+v"(ZF[5][0]), "+v"(ZF[5][1]), "+v"(ZF[5][2]) :: "memory");
                    f32x4 wc = wq; float g_ = gq; asm volatile("" : "+v"(wc), "+v"(g_));
                    SCAN_ISSUE(cp + 2, er, ar, zr);
                    { const int rn_ = ABS_ROW(kbase + cp + 2); wq = *(const f32x4*)(wabs + (size_t)rn_ * NUP); gq = nfa[rn_];
                      const unsigned b0 = __builtin_bit_cast(unsigned, wc[0] * g_) & 0x7fffffffu, b1 = __builtin_bit_cast(unsigned, wc[1] * g_) & 0x7fffffffu, b2 = __builtin_bit_cast(unsigned, wc[2] * g_) & 0x7fffffffu, b3 = __builtin_bit_cast(unsigned, wc[3] * g_) & 0x7fffffffu;
                      am0 = b0 > am0 ? b0 : am0; am1 = b1 > am1 ? b1 : am1; am2 = b2 > am2 ? b2 : am2; am3 = b3 > am3 ? b3 : am3; }
                    SCAN_PREP(cp);
                    SCAN_BAR();
                }
#undef ABS_ROW
                SCAN_BAR(); SCAN_BAR();
            } else {
                SCAN_BAR();
                for (int c2 = 0; c2 < nch; ++c2) { SCAN_RUN(c2); SCAN_BAR(); SCAN_FLUSH(c2); }
                SCAN_BAR();
            }
#undef SCAN_ISSUE
#undef SCAN_BAR
#undef SCAN_PREP
#undef SCAN_RUN
#undef SCAN_FLUSH
            __syncthreads();
        }
        if (role == 1 && abs_in_scan) { unsigned* dst = (unsigned*)(ctl + CW_WMAX) + 256 * acb + 4 * F.lane; atomicMax(dst + 0, am0); atomicMax(dst + 1, am1); atomicMax(dst + 2, am2); atomicMax(dst + 3, am3); }
#undef CVT4
#undef CAT8
#undef MFMA32
#undef MFMA16
        SEAM(4);
    }
    if (IN(5)) {
        {
            pg8::SchedGrid S{(const char*)A_gate, (const char*)Wt_gate, 512, 512, MTOK / 256, 8, F.G, F.bid};
            pg8::EpiGate E{CAT, YF, ZH + (size_t)64 * MTOK * 64, SBN, ARGIN(I_GNG), ARGIN(I_GNB), ARGIN(I_MU) + 4096, xs};
            pg8::gemm_phase<pg8::EpiGate, pg8::SchedGrid, true, true>(F.lds, 512, 512, 512, S, E);
        }
        __syncthreads();
        {
            constexpr int WS_LD = 136;
            LAS bf16_t* Wl = (LAS bf16_t*)F.lds;
            LAS bf16_t* Vt = (LAS bf16_t*)(F.lds + 128 * WS_LD * 2);
            LAS float* st = (LAS float*)(F.lds + 128 * WS_LD * 2 + 256 * WS_LD * 2);
            const float* lnst = (const float*)(ctl + CW_LN);
            const int fr = F.lane & 15, fq = F.lane >> 4;
            for (int it = F.bid; it < 192 * 4; it += F.G) {
                const int ck = it >> 2, h = it & 3, t0 = ck * 128;
                if (F.tid < 128) { const float s1 = lnst[2 * (t0 + F.tid)], s2 = lnst[2 * (t0 + F.tid) + 1];
                    const float mean = s1 * (1.f / 2048.f), var = fmaxf(s2 * (1.f / 2048.f) - mean * mean, 0.f);
                    st[2 * F.tid] = mean; st[2 * F.tid + 1] = __builtin_amdgcn_rsqf(var + LN_EPS); }
                { const float* wsrc = ARGIN(I_WS) + (size_t)h * 128 * 128;
                  for (int i = F.tid; i < 128 * 128 / 4; i += 512) { const f32x4 v = ((const f32x4*)wsrc)[i]; const int p = (4 * i) >> 7, q = (4 * i) & 127;
                      u32x2 w; w.x = cvt_pk_bf16(v[0], v[1]); w.y = cvt_pk_bf16(v[2], v[3]); *(LAS u32x2*)(Wl + p * WS_LD + q) = w; } }
                LDS_WAIT(); __syncthreads();
                for (int db = 0; db < 2; ++db) {
                    const int d0 = h * 512 + db * 256;
                    const int oct = F.lane & 7, qp = F.lane >> 3;
                    for (int wi = F.wave; wi < 32; wi += 8) {
                        const int qb = (wi >> 2) * 16, cb = (wi & 3) * 64, q = qb + 2 * qp, dl = cb + 8 * oct;
                        const bf16_t* vp = ZA + (size_t)(t0 + q) * DM + 2048 + d0 + dl;
                        float a[8], b[8]; unpack8(*(const u32x4*)vp, a); unpack8(*(const u32x4*)(vp + DM), b);
                        const float m0 = st[2 * q], r0 = st[2 * q + 1], m1 = st[2 * q + 2], r1 = st[2 * q + 3];
                        const f32x4 lg0 = *(const f32x4*)(ARGIN(I_LNG) + d0 + dl), lg1 = *(const f32x4*)(ARGIN(I_LNG) + d0 + dl + 4), lb0 = *(const f32x4*)(ARGIN(I_LNB) + d0 + dl), lb1 = *(const f32x4*)(ARGIN(I_LNB) + d0 + dl + 4);
#pragma unroll
                        for (int e = 0; e < 8; ++e) { const float g_ = e < 4 ? lg0[e & 3] : lg1[e & 3], b_ = e < 4 ? lb0[e & 3] : lb1[e & 3];
                            const int d = dl + e, slot = (d & ~31) + 16 * ((d >> 2) & 1) + 4 * ((d >> 3) & 3) + (d & 3);
                            *(LAS unsigned*)(Vt + slot * WS_LD + q) = cvt_pk_bf16((a[e] - m0) * r0 * g_ + b_, (b[e] - m1) * r1 * g_ + b_); }
                    }
                    LDS_WAIT(); __syncthreads();
                    f32x4 acc[8][2];
#pragma unroll
                    for (int pt = 0; pt < 8; ++pt) { acc[pt][0] = (f32x4){0.f, 0.f, 0.f, 0.f}; acc[pt][1] = (f32x4){0.f, 0.f, 0.f, 0.f}; }
#pragma unroll
                    for (int ks = 0; ks < 4; ++ks) {
                        bf16x8 bfr[2];
#pragma unroll
                        for (int dt = 0; dt < 2; ++dt) bfr[dt] = *(const LAS bf16x8*)(Vt + (32 * F.wave + 16 * dt + fr) * WS_LD + 32 * ks + 8 * fq);
#pragma unroll
                        for (int pt = 0; pt < 8; ++pt) { const bf16x8 afr = *(const LAS bf16x8*)(Wl + (16 * pt + fr) * WS_LD + 32 * ks + 8 * fq);
                            acc[pt][0] = __builtin_amdgcn_mfma_f32_16x16x32_bf16(bfr[0], afr, acc[pt][0], 0, 0, 0);
                            acc[pt][1] = __builtin_amdgcn_mfma_f32_16x16x32_bf16(bfr[1], afr, acc[pt][1], 0, 0, 0); }
                    }
#pragma unroll
                    for (int pt = 0; pt < 8; ++pt) { const int p = 16 * pt + fr; const float bs = ARGIN(I_BS)[h * 128 + p];
                        const int col = d0 + 32 * F.wave + 8 * fq;
                        float uu[8]; unpack8(*(const u32x4*)(ZA + (size_t)(t0 + p) * DM + col), uu);
                        float o[8];
#pragma unroll
                        for (int e = 0; e < 4; ++e) { o[e] = uu[e] * (acc[pt][0][e] + bs); o[4 + e] = uu[4 + e] * (acc[pt][1][e] + bs); }
                        *(u32x4*)(CAT + (size_t)(t0 + p) * DM + col) = pack8(o); }
                    __syncthreads();
                }
            }
        }
        SEAM(5);
    }
    if (IN(6)) { }
    if (IN(7)) {
        pg8::SchedGrid S{(const char*)CAT, (const char*)Wt_out, DM, DM, MTOK / 256, DM / 256, F.G, F.bid};
        pg8::EpiRes E{ARGIN(I_XP), ARGIN(I_XS), X1B, rep ? ssd : ss1};
        pg8::gemm_phase<pg8::EpiRes, pg8::SchedGrid, true, true>(F.lds, DM, DM, DM, S, E);
        {
            pg8::SchedGrid S2{(const char*)memn, (const char*)Wt_kv, DM, DM, 2048 / 256, 2 * DM / 256, F.G, F.bid};
            pg8::EpiBf16<0> E2{KVB, 2 * DM, nullptr, nullptr, nullptr, nullptr, nullptr};
            pg8::gemm_phase<pg8::EpiBf16<0>, pg8::SchedGrid, true, true>(F.lds, DM, DM, DM, S2, E2); }
        SEAM(7);
    }
    if (IN(8)) {
        struct SchedKW { const char* KV; const char* WQ; int G, c;
            __device__ __forceinline__ bool next(int i, pg8::Unit& u) const {
                const long L = (long)i * G + c; if (L >= 512) return false;
                const int b = (int)L >> 6, r = (int)L & 63, h = r >> 4, pn = r & 15; u.pm = b * 4 + h; u.pn = pn; u.z = 0; u.pad = 0;
                u.A = KV + ((size_t)(b * 256) * (2 * DM) + h * 1024) * 2; u.B = WQ + ((size_t)(pn * 256) * DM + h * 1024) * 2; return true; } };
        SchedKW S{(const char*)KVB, (const char*)WQR, F.G, F.bid};
        pg8::EpiBf16<0> E{KWt, DM, nullptr, nullptr, nullptr, nullptr, nullptr};
        pg8::gemm_phase<pg8::EpiBf16<0>, SchedKW, true, true>(F.lds, 1024, 2 * DM, DM, S, E);
        {
            struct SchedVW { const char* WO; const char* KV; int G, c;
                __device__ __forceinline__ bool next(int i, pg8::Unit& u) const {
                    if (c < 0) return false;
                    const long L = (long)i * G + c; if (L >= 512) return false;
                    const int b = (int)L >> 6, r = (int)L & 63, pm = r >> 2, h = r & 3; u.pm = b * 16 + pm; u.pn = h; u.z = 0; u.pad = 0;
                    u.A = WO + ((size_t)(pm * 256) * DM + h * 1024) * 2; u.B = KV + ((size_t)(b * 256) * (2 * DM) + DM + h * 1024) * 2; return true; } };
            SchedVW S{(const char*)Wt_o, (const char*)KVB, F.G, F.bid};
            pg8::EpiBf16<0> E{VWt, 1024, nullptr, nullptr, nullptr, nullptr, nullptr};
            pg8::gemm_phase<pg8::EpiBf16<0>, SchedVW, true, true>(F.lds, 1024, DM, 2 * DM, S, E); }
        SEAM(8);
    }
    if (IN(9)) {
        {   struct SchedS { const char* X; const char* KW; int G, c;
                __device__ __forceinline__ bool next(int i, pg8::Unit& u) const {
                    const long L = (long)i * G + c; if (L >= 384) return false;
                    u.pm = (int)L >> 2; u.pn = (int)L & 3; const int b = seq_of_row(u.pm * 256); u.z = b; u.pad = 0;
                    u.A = X + (size_t)u.pm * 256 * DM * 2; u.B = KW + ((size_t)(b * 1024 + u.pn * 256) * DM) * 2; return true; } };
            SchedS S{(const char*)X1B, (const char*)KWt, F.G, F.bid};
            pg8::EpiSoftmax E{PB, xs, ss1};
            pg8::gemm_phase<pg8::EpiSoftmax, SchedS, true, true>(F.lds, DM, DM, DM, S, E); }
        {
            const int n2 = (384 > F.G && 384 <= 2 * F.G) ? 384 - F.G : 0;
            if (n2 && F.bid >= n2) { LAS float* scr = (LAS float*)(F.lds + F.wave * 16384);
                convert_items_i8(ARGIN(I_WUP), DM, NUP, WupQ, ARGIN(I_NFFN), wmaxf, scr, (F.bid - n2) * NWAVES + F.wave, UP_EARLY_ITEMS, (F.G - n2) * NWAVES, F.lane); } }
        SEAM(9);
    }
    if (IN(10)) { }
    if (IN(11)) {
        struct SchedA { const char* P; const char* VW; int G, c;
            __device__ __forceinline__ bool next(int i, pg8::Unit& u) const {
                const long L = (long)i * G + c; if (L >= 1536) return false;
                pg8::tile_order((int)L, 96, 16, u.pm, u.pn); const int b = seq_of_row(u.pm * 256); u.z = b; u.pad = 0;
                u.A = P + (size_t)u.pm * 256 * 1024 * 2; u.B = VW + ((size_t)(b * 4096 + u.pn * 256) * 1024) * 2; return true; } };
        SchedA S{(const char*)PB, (const char*)VWt, F.G, F.bid};
        pg8::EpiRes E{nullptr, nullptr, rep ? (bf16_t*)(ws + WS_Z + 256 * MiB) : X1B, rep ? ssd : ss2};
        pg8::gemm_phase<pg8::EpiRes, SchedA, true, true>(F.lds, 1024, 1024, 1024, S, E);
        if (!rep) {
            LAS float* scr = (LAS float*)(F.lds + F.wave * 16384);
            constexpr int I_UP = 64 * (NUP / 32);
            const int early = (384 > F.G && 384 <= 2 * F.G) ? UP_EARLY_ITEMS : 0;
            convert_items_i8(ARGIN(I_WUP), DM, NUP, WupQ, ARGIN(I_NFFN), wmaxf, scr, early + gw, I_UP, NGW, F.lane); }
        SEAM(11);
    }
    if (IN(12)) {
        u32x4 cur[8]; float s2c = 0.f;
        if (gw < MTOK) { const u32x4* x0 = (const u32x4*)(X1B + (size_t)gw * DM);
#pragma unroll
            for (int j = 0; j < 8; ++j) cur[j] = x0[F.lane + 64 * j];
            s2c = ss2[gw]; }
        for (int row = gw; row < MTOK; row += NGW) {
            const int nrow = row + NGW < MTOK ? row + NGW : row;
            const u32x4* xn = (const u32x4*)(X1B + (size_t)nrow * DM); u32x4 nxt[8];
#pragma unroll
            for (int j = 0; j < 8; ++j) nxt[j] = xn[F.lane + 64 * j];
            const float s2n = ss2[nrow], ss2r = s2c;
            const int prow = (row & ~63) + 16 * (row & 3) + ((row >> 2) & 15);
            float f[8][8]; float mx = 0.f;
#pragma unroll
            for (int j = 0; j < 8; ++j) { unpack8(cur[j], f[j]);
#pragma unroll
                for (int e = 0; e < 8; ++e) mx = fmaxf(mx, fabsf(f[j][e])); }
#pragma unroll
            for (int o = 1; o < 64; o <<= 1) mx = fmaxf(mx, __shfl_xor(mx, o));
            mx = fmaxf(mx, 1e-30f);
            const float iq = 127.0f * __builtin_amdgcn_rcpf(mx);
#pragma unroll
            for (int j = 0; j < 8; ++j) { u32x2 o; o.x = pack4_i8(f[j][0] * iq, f[j][1] * iq, f[j][2] * iq, f[j][3] * iq); o.y = pack4_i8(f[j][4] * iq, f[j][5] * iq, f[j][6] * iq, f[j][7] * iq);
                ((u32x2*)(X2Q + (size_t)prow * DM))[F.lane + 64 * j] = o; }
            if (F.lane == 0) zsc[row] = __builtin_amdgcn_rsqf(ss2r * (1.0f / DM) + RMS_EPS) * (mx * (1.0f / 127.0f));
#pragma unroll
            for (int j = 0; j < 8; ++j) cur[j] = nxt[j];
            s2c = s2n;
        }
        SEAM(12);
    }
    if (IN(13)) {
        pg8::SchedGrid S{(const char*)X2Q, (const char*)WupQ, DM / 2, DM / 2, MTOK / 256, NUP / 256, F.G, F.bid};
        pg8::EpiUp E{ACT, ZBf, zsc, wmaxf, ARGIN(I_CW), ARGIN(I_CB), xs};
        pg8::gemm_phase<pg8::EpiUp, pg8::SchedGrid, true, true, true>(F.lds, DM / 2, DM / 2, DM / 2, S, E);
        {
            const int nun = (MTOK / 256) * (NUP / 256), rounds = (nun + F.G - 1) / F.G, nbusy = nun - (rounds - 1) * F.G, nidle = F.G - nbusy;
            LAS float* scr = (LAS float*)(F.lds + F.wave * 16384);
            constexpr int I_DN = (DFF / 64) * (DM / 32);
            const int w0 = (nidle > 0) ? ((F.bid - nbusy) * NWAVES + F.wave) : gw, nw = (nidle > 0) ? nidle * NWAVES : NGW;
            if (nidle == 0 || F.bid >= nbusy) convert_items<0>(ARGIN(I_WDOWN), DFF, DM, Wt_down, nullptr, scr, w0, I_DN, nw, F.lane);
        }
        SEAM(13);
    }
    if (IN(14)) {
        const float* cw = ARGIN(I_CW); const float* cb = ARGIN(I_CB);
        for (int it = F.bid * 512 + F.tid; it < 96 * 2 * (DFF / 4); it += F.G * 512) {
            const int oq = it % (DFF / 4), pe = it / (DFF / 4), pm = pe >> 1, e = pe & 1;
            const int row = pm * 256 + (e ? 255 : 0), s0 = seq_start_of_row(row), T = seq_len_of_row(row), t = row - s0;
            const bool okp = e ? true : (t > 0), okn = e ? (t < T - 1) : true;
            const float* zc = ZBf + ((size_t)pm * 4 + (e ? 3 : 0)) * NUP;
            const float* zp = e ? ZBf + ((size_t)pm * 4 + 2) * NUP : (okp ? ZBf + ((size_t)(pm - 1) * 4 + 3) * NUP : zc);
            const float* zn = e ? (okn ? ZBf + ((size_t)(pm + 1) * 4 + 0) * NUP : zc) : ZBf + ((size_t)pm * 4 + 1) * NUP;
            f32x4 cz[2];
#pragma unroll
            for (int bj = 0; bj < 2; ++bj) { const int cc = bj * DFF + 4 * oq;
                f32x4 p_ = *(const f32x4*)(zp + cc), n_ = *(const f32x4*)(zn + cc); const f32x4 c_ = *(const f32x4*)(zc + cc);
                if (!okp) p_ = (f32x4){0.f, 0.f, 0.f, 0.f}; if (!okn) n_ = (f32x4){0.f, 0.f, 0.f, 0.f};
                cz[bj] = *(const f32x4*)(cw + cc) * p_ + *(const f32x4*)(cw + NUP + cc) * c_ + *(const f32x4*)(cw + 2 * NUP + cc) * n_ + *(const f32x4*)(cb + cc); }
            float o[4];
#pragma unroll
            for (int j = 0; j < 4; ++j) o[j] = cz[0][j] * sigmoidf_(cz[0][j]) * cz[1][j];
            *(u32x2*)(ACT + (size_t)row * DFF + 4 * oq) = (u32x2){cvt_pk_bf16(o[0], o[1]), cvt_pk_bf16(o[2], o[3])};
        }
        SEAM(14);
    }
    if (IN(15)) {
        pg8::SchedGrid S{(const char*)ACT, (const char*)Wt_down, DFF, DFF, MTOK / 256, DM / 256, F.G, F.bid};
        pg8::EpiRes E{nullptr, nullptr, rep ? (bf16_t*)(ws + WS_Z + 256 * MiB) : X1B, rep ? ssd : ss3};
        pg8::gemm_phase<pg8::EpiRes, pg8::SchedGrid, true, true>(F.lds, DFF, DFF, DFF, S, E);
        SEAM(15);
    }
    if (IN(16)) {
        const float* g = ARGIN(I_NOUT);
        f32x4 G0[8], G1[8];
#pragma unroll
        for (int j = 0; j < 8; ++j) { G0[j] = ((const f32x4*)g)[2 * (F.lane + 64 * j)]; G1[j] = ((const f32x4*)g)[2 * (F.lane + 64 * j) + 1]; }
        u32x4 cur[8]; float ssc = 0.f;
        if (gw < MTOK) { const u32x4* x0 = (const u32x4*)(X1B + (size_t)gw * DM);
#pragma unroll
            for (int j = 0; j < 8; ++j) cur[j] = x0[F.lane + 64 * j];
            ssc = ss3[gw]; }
        for (int row = gw; row < MTOK; row += NGW) {
            const int nrow = row + NGW < MTOK ? row + NGW : row;
            const u32x4* xn = (const u32x4*)(X1B + (size_t)nrow * DM); u32x4 nxt[8];
#pragma unroll
            for (int j = 0; j < 8; ++j) nxt[j] = xn[F.lane + 64 * j];
            const float ssn = ss3[nrow];
            const float rs = __builtin_amdgcn_rsqf(ssc * (1.f / DM) + RMS_EPS);
            f32x4* yr = (f32x4*)(ARG_OUT + (size_t)row * DM);
#pragma unroll
            for (int j = 0; j < 8; ++j) { float f[8]; unpack8(cur[j], f);
                yr[2 * (F.lane + 64 * j)] = (f32x4){f[0], f[1], f[2], f[3]} * rs * G0[j]; yr[2 * (F.lane + 64 * j) + 1] = (f32x4){f[4], f[5], f[6], f[7]} * rs * G1[j]; }
#pragma unroll
            for (int j = 0; j < 8; ++j) cur[j] = nxt[j];
            ssc = ssn;
        }
    }
#undef IN
#undef SEAM
}

#ifndef MK_SINGLE
#define MK_SINGLE 1
#endif
extern "C" void kernel_launch(void* const* d_in, const int* in_sizes, int n_in, void* d_out, int out_size, void* d_ws, size_t ws_size, hipStream_t stream) {
    static int grid = 0;
    if (grid == 0) {
        if (n_in != 33 || out_size != MTOK * DM || ws_size < WS_END) { fprintf(stderr, "kernel_launch: unexpected shapes (n_in %d out %d ws %zu, need %zu)\n", n_in, out_size, ws_size, (size_t)WS_END); grid = -1; return; }
        int dev = 0, cus = 0, per_cu = 0;
        if (hipGetDevice(&dev) != hipSuccess || hipDeviceGetAttribute(&cus, hipDeviceAttributeMultiprocessorCount, dev) != hipSuccess) { grid = -1; return; }
        if (hipFuncSetAttribute((const void*)fwd, hipFuncAttributeMaxDynamicSharedMemorySize, LDS_BYTES) != hipSuccess) { fprintf(stderr, "kernel_launch: hipFuncSetAttribute failed\n"); grid = -1; return; }
        if (hipOccupancyMaxActiveBlocksPerMultiprocessor(&per_cu, (const void*)fwd, NWAVES * 64, LDS_BYTES) != hipSuccess || per_cu < 1) fprintf(stderr, "kernel_launch: occupancy query says %d\n", per_cu);
        (void)hipGetLastError();
        grid = cus;
    }
    if (grid < 0) return;
    (void)hipMemsetAsync((char*)d_ws + WS_CTL, 0, CTL_ZERO_BYTES, stream);
    Args a{};
    for (int i = 0; i < 33; ++i) a.in[i] = (const float*)d_in[i];
    a.out = (float*)d_out; a.ws = (unsigned char*)d_ws;
#if MK_SINGLE
    a.ph_lo = 0; a.ph_hi = NPH + 1;
    hipLaunchKernelGGL(fwd, dim3(grid), dim3(NWAVES * 64), LDS_BYTES, stream, a);
#else
    for (int p = 0; p <= NPH; ++p) { a.ph_lo = p; a.ph_hi = p + 1; a.rep = 0; hipLaunchKernelGGL(fwd, dim3(grid), dim3(NWAVES * 64), LDS_BYTES, stream, a);
#ifdef PROBE_MASK2
        if (((PROBE_MASK2) >> p) & 1) { a.rep = 1; hipLaunchKernelGGL(fwd, dim3(grid), dim3(NWAVES * 64), LDS_BYTES, stream, a); }
#endif
    }
#endif
}
```
